# Optimizing an MI355X kernel written in HIP

```python
import math
import jax
import jax.numpy as jnp
from jax import lax
import numpy as np


D_MODEL = 1024
BATCH = 8
SEQ = 4096
DEPTH = 4

HEAD_DIM = 64
N_Q_HEADS = 8
N_KV_HEADS = 2
Q_PER_KV = N_Q_HEADS // N_KV_HEADS
ATTN_WIDTH = N_Q_HEADS * HEAD_DIM
KV_WIDTH = N_KV_HEADS * HEAD_DIM
N_BRANCH = 3
SSM_WIDTH = D_MODEL - ATTN_WIDTH
SSM_GROUP = 16
N_SSM_GROUPS = SSM_WIDTH // SSM_GROUP
SSM_STATE = 64
MIX_WIDTH = ATTN_WIDTH + SSM_WIDTH
PROJ_WIDTH = ATTN_WIDTH + 6 * KV_WIDTH + N_BRANCH * N_Q_HEADS + SSM_WIDTH

CMP_LEN = 32
CMP_STRIDE = 16
SLC_LEN = 64
N_SEL = 16
WINDOW = 512
Q_BLOCK = 128

DT_MIN = 1e-3
DT_MAX = 1e-1

D_FF = 2816
N_EXPERTS = 8
TOP_K = 2
N_DENSE = (DEPTH + 1) // 2
N_MOE = DEPTH // 2

DEEPNORM_ALPHA = (2.0 * DEPTH) ** 0.25
DEEPNORM_BETA = (8.0 * DEPTH) ** -0.25
LN_EPS = 1e-5
RMS_EPS = 1e-6

kernel_name = 'hybrid_nsa_s5_moe_deepnorm_block'


def layer_norm(x, g, b):
    x32 = x.astype(jnp.float32)
    mu = jnp.mean(x32, axis=-1, keepdims=True)
    var = jnp.mean(jnp.square(x32 - mu), axis=-1, keepdims=True)
    y = (x32 - mu) * lax.rsqrt(var + LN_EPS)
    return (y * g.astype(jnp.float32) + b.astype(jnp.float32)).astype(x.dtype)


def rms_norm(x, g):
    x32 = x.astype(jnp.float32)
    y = x32 * lax.rsqrt(jnp.mean(jnp.square(x32), axis=-1, keepdims=True) + RMS_EPS)
    return (y * g.astype(jnp.float32)).astype(x.dtype)


def masked_softmax(s, mask):
    s = jnp.where(mask, s.astype(jnp.float32), -jnp.inf)
    m = jnp.max(s, axis=-1, keepdims=True)
    m = jnp.where(jnp.isfinite(m), m, 0.0)
    e = jnp.exp(s - m)
    den = jnp.sum(e, axis=-1, keepdims=True)
    return e / jnp.where(den > 0, den, 1.0)


def swiglu(h, w_gate, w_up, w_down):
    return (jax.nn.silu(h @ w_gate) * (h @ w_up)) @ w_down


def moe_swiglu(h, router, w_gate, w_up, w_down):
    logits = (h @ router).astype(jnp.float32)
    top_val, top_idx = lax.top_k(logits, TOP_K)
    top_w = jax.nn.softmax(top_val, axis=-1)
    gate = jnp.sum(jax.nn.one_hot(top_idx, N_EXPERTS, dtype=jnp.float32) * top_w[..., None],
                   axis=-2).astype(h.dtype)
    out = jnp.zeros_like(h)
    for e in range(N_EXPERTS):
        out = out + gate[..., e:e + 1] * swiglu(h, w_gate[e], w_up[e], w_down[e])
    return out


def compress_blocks(k, pos, w1, w2):
    L = k.shape[1]
    n_cmp = (L - CMP_LEN) // CMP_STRIDE + 1
    idx = np.arange(n_cmp)[:, None] * CMP_STRIDE + np.arange(CMP_LEN)[None, :]
    blocks = k[:, idx] + pos[None, None, :, None, :]
    hid = jax.nn.gelu(jnp.einsum('bnlhd,ldf->bnhf', blocks, w1))
    return jnp.einsum('bnhf,fd->bnhd', hid, w2)


def nsa_attention(q, k_cmp, v_cmp, k_slc, v_slc, k_win, v_win, gates):
    B, L = q.shape[0], q.shape[1]
    scale = HEAD_DIM ** -0.5
    n_cmp = k_cmp.shape[1]
    n_slc = L // SLC_LEN
    n_sel = min(N_SEL, n_slc)
    cmp_end = jnp.arange(n_cmp) * CMP_STRIDE + CMP_LEN - 1
    cs = np.arange(n_cmp)[:, None] * CMP_STRIDE
    ss = np.arange(n_slc)[None, :] * SLC_LEN
    overlap = jnp.asarray((cs < ss + SLC_LEN) & (cs + CMP_LEN > ss), jnp.float32)
    kb = k_slc.reshape(B, n_slc, SLC_LEN, N_KV_HEADS, HEAD_DIM).transpose(0, 3, 1, 2, 4)
    vb = v_slc.reshape(B, n_slc, SLC_LEN, N_KV_HEADS, HEAD_DIM).transpose(0, 3, 1, 2, 4)
    kw = jnp.pad(k_win, ((0, 0), (WINDOW, 0), (0, 0), (0, 0)))
    vw = jnp.pad(v_win, ((0, 0), (WINDOW, 0), (0, 0), (0, 0)))
    gather = jax.vmap(jax.vmap(lambda blocks, idx: blocks[idx]))
    blk = jnp.arange(n_slc)

    def block(i):
        qs = i * Q_BLOCK
        qb = lax.dynamic_slice_in_dim(q, qs, Q_BLOCK, axis=1) * scale
        gb = lax.dynamic_slice_in_dim(gates, qs, Q_BLOCK, axis=1)
        t = qs + jnp.arange(Q_BLOCK)

        s = jnp.einsum('bqhgd,bnhd->bhgqn', qb, k_cmp)
        p_cmp = masked_softmax(s, cmp_end[None, :] <= t[:, None])
        o_cmp = jnp.einsum('bhgqn,bnhd->bqhgd', p_cmp.astype(v_cmp.dtype), v_cmp)

        imp = jnp.einsum('bhgqn,ns->bhqs', p_cmp, overlap)
        cur = t // SLC_LEN
        forced = (blk[None, :] == 0) | (blk[None, :] == cur[:, None]) | (blk[None, :] == cur[:, None] - 1)
        causal = blk[None, :] * SLC_LEN <= t[:, None]
        score = jnp.where(causal, jnp.where(forced, jnp.inf, imp), -jnp.inf)
        top_val, top_idx = lax.top_k(score, n_sel)
        sel_valid = top_val > -jnp.inf
        k_sel = gather(kb, top_idx)
        v_sel = gather(vb, top_idx)
        kpos = top_idx[..., None] * SLC_LEN + jnp.arange(SLC_LEN)
        m_sel = sel_valid[..., None] & (kpos <= t[None, None, :, None, None])
        s = jnp.einsum('bqhgd,bhqjld->bhgqjl', qb, k_sel).reshape(B, N_KV_HEADS, Q_PER_KV, Q_BLOCK, n_sel * SLC_LEN)
        p = masked_softmax(s, m_sel.reshape(B, N_KV_HEADS, Q_BLOCK, n_sel * SLC_LEN)[:, :, None])
        o_slc = jnp.einsum('bhgqk,bhqkd->bqhgd', p.astype(v_sel.dtype),
                           v_sel.reshape(B, N_KV_HEADS, Q_BLOCK, n_sel * SLC_LEN, HEAD_DIM))

        kwb = lax.dynamic_slice_in_dim(kw, qs, WINDOW + Q_BLOCK, axis=1)
        vwb = lax.dynamic_slice_in_dim(vw, qs, WINDOW + Q_BLOCK, axis=1)
        wpos = qs - WINDOW + jnp.arange(WINDOW + Q_BLOCK)
        dist = t[:, None] - wpos[None, :]
        m_win = (dist >= 0) & (dist < WINDOW) & (wpos[None, :] >= 0)
        s = jnp.einsum('bqhgd,bkhd->bhgqk', qb, kwb)
        p = masked_softmax(s, m_win)
        o_win = jnp.einsum('bhgqk,bkhd->bqhgd', p.astype(vwb.dtype), vwb)

        g = jax.nn.sigmoid(gb.astype(jnp.float32))
        o = (g[..., 0:1] * o_cmp.astype(jnp.float32) + g[..., 1:2] * o_slc.astype(jnp.float32)
             + g[..., 2:3] * o_win.astype(jnp.float32))
        return o.astype(q.dtype)

    out = lax.map(block, jnp.arange(L // Q_BLOCK))
    return out.transpose(1, 0, 2, 3, 4, 5).reshape(B, L, ATTN_WIDTH)


def cplx(re, im):
    return lax.complex(re.astype(jnp.float32), im.astype(jnp.float32))


def s5_ssm(u, a_re, a_im, log_dt, b_re, b_im, c_re, c_im, d_skip):
    B, L = u.shape[0], u.shape[1]
    u32 = u.astype(jnp.float32).reshape(B, L, N_SSM_GROUPS, SSM_GROUP)
    a = cplx(a_re, a_im)
    dt = jnp.exp(log_dt.astype(jnp.float32))[:, None]
    a_bar = jnp.exp(a * dt)
    b_bar = ((a_bar - 1.0) / a)[..., None] * cplx(b_re, b_im)
    bu = jnp.einsum('blgh,gph->blgp', u32.astype(jnp.complex64), b_bar)
    a_seq = jnp.broadcast_to(a_bar, (1, L) + a_bar.shape)

    def combine(left, right):
        return (right[0] * left[0], right[0] * left[1] + right[1])

    _, states = lax.associative_scan(combine, (a_seq, bu), axis=1)
    y = jnp.einsum('blgp,ghp->blgh', states, cplx(c_re, c_im)).real + d_skip.astype(jnp.float32) * u32
    return y.reshape(B, L, SSM_WIDTH)


def hybrid_mixer(h, w_in, cmp_pos_k, cmp_pos_v, cmp_w1_k, cmp_w2_k, cmp_w1_v, cmp_w2_v,
                 a_re, a_im, log_dt, b_re, b_im, c_re, c_im, d_skip, w_glu, norm_attn, norm_ssm, w_out):
    B, L = h.shape[0], h.shape[1]
    sizes = [ATTN_WIDTH] + [KV_WIDTH] * 6 + [N_BRANCH * N_Q_HEADS, SSM_WIDTH]
    cuts = np.cumsum(sizes)[:-1].tolist()
    q, kc, vc, ks, vs, kw, vw, g, u = jnp.split(h @ w_in, cuts, axis=-1)

    def kv(t):
        return t.reshape(B, L, N_KV_HEADS, HEAD_DIM)

    k_cmp = compress_blocks(kv(kc), cmp_pos_k, cmp_w1_k, cmp_w2_k)
    v_cmp = compress_blocks(kv(vc), cmp_pos_v, cmp_w1_v, cmp_w2_v)
    o_attn = nsa_attention(q.reshape(B, L, N_KV_HEADS, Q_PER_KV, HEAD_DIM), k_cmp, v_cmp,
                           kv(ks), kv(vs), kv(kw), kv(vw),
                           g.reshape(B, L, N_KV_HEADS, Q_PER_KV, N_BRANCH))
    y = jax.nn.gelu(s5_ssm(u, a_re, a_im, log_dt, b_re, b_im, c_re, c_im, d_skip).astype(h.dtype))
    o_ssm = y * jax.nn.sigmoid(y @ w_glu)
    o = jnp.concatenate([rms_norm(o_attn, norm_attn), rms_norm(o_ssm, norm_ssm)], axis=-1)
    return o @ w_out


def setup_inputs(seed: int = 0) -> dict:
    key = jax.random.key(seed)
    keys = jax.random.split(key, 32)

    def nrm(i, shape, scale):
        return scale * jax.random.normal(keys[i], shape, jnp.float32)

    G, P, H = N_SSM_GROUPS, SSM_STATE, SSM_GROUP
    n_idx = jnp.arange(P, dtype=jnp.float32)
    return {
        'x': nrm(0, (BATCH, SEQ, D_MODEL), 1.0),
        'c': nrm(1, (BATCH, D_MODEL), 1.0),
        'w_in': nrm(2, (DEPTH, D_MODEL, PROJ_WIDTH), D_MODEL ** -0.5),
        'cmp_pos_k': nrm(3, (DEPTH, CMP_LEN, HEAD_DIM), 0.1),
        'cmp_pos_v': nrm(4, (DEPTH, CMP_LEN, HEAD_DIM), 0.1),
        'cmp_w1_k': nrm(5, (DEPTH, CMP_LEN, HEAD_DIM, HEAD_DIM), (CMP_LEN * HEAD_DIM) ** -0.5),
        'cmp_w2_k': nrm(6, (DEPTH, HEAD_DIM, HEAD_DIM), HEAD_DIM ** -0.5),
        'cmp_w1_v': nrm(7, (DEPTH, CMP_LEN, HEAD_DIM, HEAD_DIM), (CMP_LEN * HEAD_DIM) ** -0.5),
        'cmp_w2_v': nrm(8, (DEPTH, HEAD_DIM, HEAD_DIM), HEAD_DIM ** -0.5),
        'ssm_a_re': -0.5 + nrm(9, (DEPTH, G, P), 0.01),
        'ssm_a_im': math.pi * n_idx + nrm(10, (DEPTH, G, P), 0.01),
        'ssm_log_dt': jax.random.uniform(keys[11], (DEPTH, G), jnp.float32, math.log(DT_MIN), math.log(DT_MAX)),
        'ssm_b_re': nrm(12, (DEPTH, G, P, H), (2.0 * H) ** -0.5),
        'ssm_b_im': nrm(13, (DEPTH, G, P, H), (2.0 * H) ** -0.5),
        'ssm_c_re': nrm(14, (DEPTH, G, H, P), (2.0 * P) ** -0.5),
        'ssm_c_im': nrm(15, (DEPTH, G, H, P), (2.0 * P) ** -0.5),
        'ssm_d': nrm(16, (DEPTH, G, H), 1.0),
        'ssm_w_glu': nrm(17, (DEPTH, SSM_WIDTH, SSM_WIDTH), SSM_WIDTH ** -0.5),
        'norm_attn': 1.0 + nrm(18, (DEPTH, ATTN_WIDTH), 0.01),
        'norm_ssm': 1.0 + nrm(19, (DEPTH, SSM_WIDTH), 0.01),
        'w_out': nrm(20, (DEPTH, MIX_WIDTH, D_MODEL), DEEPNORM_BETA * MIX_WIDTH ** -0.5),
        'ada_w': nrm(21, (DEPTH, D_MODEL, 6 * D_MODEL), 0.1 * D_MODEL ** -0.5),
        'ada_b': nrm(22, (DEPTH, 6 * D_MODEL), 0.01),
        'ln_g': 1.0 + nrm(23, (DEPTH, 2, D_MODEL), 0.01),
        'ln_b': nrm(24, (DEPTH, 2, D_MODEL), 0.01),
        'ffn_w_gate': nrm(25, (N_DENSE, D_MODEL, D_FF), D_MODEL ** -0.5),
        'ffn_w_up': nrm(26, (N_DENSE, D_MODEL, D_FF), D_MODEL ** -0.5),
        'ffn_w_down': nrm(27, (N_DENSE, D_FF, D_MODEL), DEEPNORM_BETA * D_FF ** -0.5),
        'moe_router': nrm(28, (N_MOE, D_MODEL, N_EXPERTS), D_MODEL ** -0.5),
        'moe_w_gate': nrm(29, (N_MOE, N_EXPERTS, D_MODEL, D_FF), D_MODEL ** -0.5),
        'moe_w_up': nrm(30, (N_MOE, N_EXPERTS, D_MODEL, D_FF), D_MODEL ** -0.5),
        'moe_w_down': nrm(31, (N_MOE, N_EXPERTS, D_FF, D_MODEL), DEEPNORM_BETA * D_FF ** -0.5),
    }


def reference(x, c, w_in, cmp_pos_k, cmp_pos_v, cmp_w1_k, cmp_w2_k, cmp_w1_v, cmp_w2_v,
              ssm_a_re, ssm_a_im, ssm_log_dt, ssm_b_re, ssm_b_im, ssm_c_re, ssm_c_im, ssm_d,
              ssm_w_glu, norm_attn, norm_ssm, w_out, ada_w, ada_b, ln_g, ln_b,
              ffn_w_gate, ffn_w_up, ffn_w_down, moe_router, moe_w_gate, moe_w_up, moe_w_down):
    c_act = jax.nn.silu(c)
    for l in range(DEPTH):
        mod = (c_act @ ada_w[l] + ada_b[l])[:, None, :]
        sh1, sc1, g1, sh2, sc2, g2 = jnp.split(mod, 6, axis=-1)
        y = hybrid_mixer(x * (1.0 + sc1) + sh1, w_in[l], cmp_pos_k[l], cmp_pos_v[l],
                         cmp_w1_k[l], cmp_w2_k[l], cmp_w1_v[l], cmp_w2_v[l],
                         ssm_a_re[l], ssm_a_im[l], ssm_log_dt[l], ssm_b_re[l], ssm_b_im[l],
                         ssm_c_re[l], ssm_c_im[l], ssm_d[l], ssm_w_glu[l],
                         norm_attn[l], norm_ssm[l], w_out[l])
        x = layer_norm(DEEPNORM_ALPHA * x + (1.0 + g1) * y, ln_g[l, 0], ln_b[l, 0])
        h = x * (1.0 + sc2) + sh2
        if l % 2 == 0:
            f = swiglu(h, ffn_w_gate[l // 2], ffn_w_up[l // 2], ffn_w_down[l // 2])
        else:
            f = moe_swiglu(h, moe_router[l // 2], moe_w_gate[l // 2], moe_w_up[l // 2], moe_w_down[l // 2])
        x = layer_norm(DEEPNORM_ALPHA * x + (1.0 + g2) * f, ln_g[l, 1], ln_b[l, 1])
    return x
```

```cpp
#include <hip/hip_runtime.h>
#include <cstdint>
#include <cstdio>

#define LAS __attribute__((address_space(3)))
#define GAS __attribute__((address_space(1)))
typedef unsigned short bf16_t;
typedef short bf16x8 __attribute__((ext_vector_type(8)));
typedef float f32x4 __attribute__((ext_vector_type(4)));
typedef float f32x2 __attribute__((ext_vector_type(2)));
typedef float f32x16 __attribute__((ext_vector_type(16)));
typedef unsigned u32x4 __attribute__((ext_vector_type(4)));
typedef unsigned u32x2 __attribute__((ext_vector_type(2)));

constexpr int NB = 8, SEQ = 4096, MTOK = NB * SEQ, DM = 1024, DEPTH = 4;
constexpr int PWID = 1816, NPROJ = 1792;
constexpr int COL_Q = 0, COL_KC = 512, COL_VC = 640, COL_KS = 768, COL_VS = 896, COL_KW = 1024, COL_VW = 1152, COL_U = 1280;
constexpr int DFF = 2816, NEXP = 8;
constexpr int NCMP = 255, NCMPP = 256;
constexpr int SSM_G = 32, SSM_H = 16, SSM_P = 64, SSM_T = 32;
constexpr int SSM_NCH = SEQ / SSM_T;
constexpr int SSM_ROWS = NB * SSM_NCH;
constexpr int SSM_K = SSM_T * SSM_H + 2 * SSM_P;
constexpr float LN_EPS = 1e-5f, RMS_EPS = 1e-6f;
constexpr float DN_ALPHA = 1.681792830507429f;
constexpr int NWAVES = 8, NTHREADS = 512;

constexpr size_t MiB = 1u << 20;
constexpr size_t WS_CTL = 0, CTL_ZERO_BYTES = 1 * MiB;
constexpr size_t WS_MOD = 1 * MiB;
constexpr size_t WS_MISC = 2 * MiB;
constexpr size_t WS_WIN = 3 * MiB;
constexpr size_t WS_WOUT = 17 * MiB;
constexpr size_t WS_WGLU = 25 * MiB;
constexpr size_t WS_FGU = 27 * MiB;
constexpr size_t WS_FD = 49 * MiB;
constexpr size_t WS_MGU = 60 * MiB;
constexpr size_t WS_MD = 148 * MiB;
constexpr size_t WS_SSMM = 192 * MiB;
constexpr size_t WS_SSME = 212 * MiB;
constexpr size_t WS_HM = 216 * MiB;
constexpr size_t WS_YO = 280 * MiB;
constexpr size_t WS_GATE = 344 * MiB;
constexpr size_t WS_ROUTE = 347 * MiB;
constexpr size_t WS_R = 350 * MiB;
constexpr size_t WS_PROJ = WS_R;
constexpr size_t WS_UG = WS_R + 112 * MiB;
constexpr size_t WS_SLOC = WS_R + 152 * MiB;
constexpr size_t WS_YG = WS_R + 168 * MiB;
constexpr size_t WS_O = WS_R + 200 * MiB;
constexpr size_t WS_VST = WS_R + 264 * MiB;
constexpr size_t WS_VWT = WS_R + 272 * MiB;
constexpr size_t WS_KCMP = WS_R + 280 * MiB;
constexpr size_t WS_VCMPT = WS_R + 281 * MiB;
constexpr size_t WS_XS = WS_R;
constexpr size_t WS_HID = WS_R + 132 * MiB;
constexpr size_t WS_END = WS_R + 308 * MiB;
constexpr int XS_ROWS = 67584;

constexpr int CW_BAR = 4096;
constexpr int CW_MOE = 16384;

constexpr int MS_CMPB = 0;
constexpr int MS_A32 = 1024;

constexpr int LDS_BYTES = 147456;
constexpr int MISC_OFF = 131072 + 320;

__device__ __forceinline__ unsigned f2bf(float f) { unsigned u = __builtin_bit_cast(unsigned, f); return (u + 0x7fffu + ((u >> 16) & 1u)) >> 16; }
__device__ __forceinline__ unsigned pk2(float lo, float hi) { return f2bf(lo) | (f2bf(hi) << 16); }
__device__ __forceinline__ float bf2f(unsigned short h) { return __builtin_bit_cast(float, (unsigned)h << 16); }
__device__ __forceinline__ float bflo(unsigned w) { return __builtin_bit_cast(float, w << 16); }
__device__ __forceinline__ float bfhi(unsigned w) { return __builtin_bit_cast(float, w & 0xffff0000u); }
__device__ __forceinline__ unsigned cvt_pk_bf16(float lo, float hi) { unsigned r; asm volatile("v_cvt_pk_bf16_f32 %0, %1, %2" : "=v"(r) : "v"(lo), "v"(hi)); return r; }
__device__ __forceinline__ float wave_sum(float v) {
#pragma unroll
    for (int o = 1; o < 64; o <<= 1) v += __shfl_xor(v, o);
    return v;
}
__device__ __forceinline__ float fast_exp(float x) { return __builtin_amdgcn_exp2f(x * 1.4426950408889634f); }
__device__ __forceinline__ float sigmoidf_(float x) { return __builtin_amdgcn_rcpf(1.0f + fast_exp(-x)); }
__device__ __forceinline__ float siluf_(float x) { return x * sigmoidf_(x); }
__device__ __forceinline__ float gelu_tanh(float x) {
    const float z = 0.7978845608028654f * (x + 0.044715f * x * x * x);
    const float t = 1.0f - 2.0f * __builtin_amdgcn_rcpf(1.0f + fast_exp(2.0f * z));
    return 0.5f * x * (1.0f + t);
}
#define LDS_WAIT() asm volatile("s_waitcnt lgkmcnt(0)" ::: "memory")
#define VM_WAIT() asm volatile("s_waitcnt vmcnt(0)" ::: "memory")

#define XB_TMO      128
#define XB_XCNT(j)  (256  + 64 * (j))
#define XB_XSUB(j)  (1280 + 64 * (j))
#define XB_XGEN(j)  (2304 + 64 * (j))
#define XB_TOP      3328
#define XB_TOPGEN   3392
#define XCD_BAR_WORDS 3456
#define XB_SPIN_CAP (1u << 20)
__device__ __forceinline__ unsigned xb_ld(unsigned* p)              { return __hip_atomic_load(p, __ATOMIC_RELAXED, __HIP_MEMORY_SCOPE_AGENT); }
__device__ __forceinline__ unsigned xb_add(unsigned* p, unsigned v) { return __hip_atomic_fetch_add(p, v, __ATOMIC_RELAXED, __HIP_MEMORY_SCOPE_AGENT); }
__device__ __forceinline__ unsigned xb_xcc_id() { return (unsigned)__builtin_amdgcn_s_getreg((3 << 11) | 20) & 0xFu; }
#define XB_SPIN(cond, bar) do { unsigned _sp = 0; while (cond) { __builtin_amdgcn_s_sleep(1); \
    if ((++_sp & 255u) == 0u) { if (xb_ld(&(bar)[XB_TMO])) break; if (_sp > XB_SPIN_CAP) { atomicAdd(&(bar)[XB_TMO], 1u); break; } } } } while (0)
struct XcdBarrier { unsigned* bar; unsigned x; volatile LAS unsigned* st; };
__device__ __forceinline__ XcdBarrier xcd_barrier_post(unsigned* bar, volatile LAS unsigned* st) {
    XcdBarrier b; b.bar = bar; b.x = xb_xcc_id(); b.st = st;
    if (threadIdx.x == 0) (void)xb_add(&bar[XB_XCNT(b.x)], 1u);
    return b;
}
__device__ __forceinline__ void xcd_barrier_complete(unsigned* bar, unsigned x, unsigned& nloc, unsigned& nx) {
    const unsigned G = gridDim.x * gridDim.y * gridDim.z;
    unsigned sum, cnt, mine, sp = 0u;
    for (;;) {
        sum = 0u; cnt = 0u; mine = 0u;
#pragma unroll
        for (unsigned j = 0; j < 16; ++j) { const unsigned c = xb_ld(&bar[XB_XCNT(j)]); sum += c; cnt += (c > 0u) ? 1u : 0u; mine = (j == x) ? c : mine; }
        if (sum == G) break;
        __builtin_amdgcn_s_sleep(1);
        if ((++sp & 255u) == 0u) { if (xb_ld(&bar[XB_TMO])) break; if (sp > XB_SPIN_CAP) { atomicAdd(&bar[XB_TMO], 1u); break; } }
    }
    nloc = mine > 0u ? mine : 1u; nx = cnt > 0u ? cnt : 1u;
}
__device__ __forceinline__ void xcd_barrier(const XcdBarrier& b) {
    asm volatile("s_waitcnt vmcnt(0)" ::: "memory");
    __syncthreads();
    if (threadIdx.x == 0) {
        unsigned* bar = b.bar;
        __builtin_amdgcn_s_waitcnt(0);
        unsigned nloc = b.st[0], nx = b.st[1];
        if (nloc == 0u) { xcd_barrier_complete(bar, b.x, nloc, nx); b.st[0] = nloc; b.st[1] = nx; }
        const unsigned old = xb_add(&bar[XB_XSUB(b.x)], 1u);
        const unsigned gen = old / nloc;
        if (old + 1u == (gen + 1u) * nloc) {
            __builtin_amdgcn_fence(__ATOMIC_RELEASE, "agent");
            asm volatile("s_waitcnt vmcnt(0)" ::: "memory");
            const unsigned og = xb_add(&bar[XB_TOP], 1u);
            const unsigned tg = og / nx;
            if (og + 1u == (tg + 1u) * nx) xb_add(&bar[XB_TOPGEN], 1u);
            else XB_SPIN(xb_ld(&bar[XB_TOPGEN]) == tg, bar);
            __builtin_amdgcn_fence(__ATOMIC_ACQUIRE, "agent");
            xb_add(&bar[XB_XGEN(b.x)], 1u);
            asm volatile("s_waitcnt vmcnt(0)" ::: "memory");
        } else {
            XB_SPIN(xb_ld(&bar[XB_XGEN(b.x)]) == gen, bar);
            __builtin_amdgcn_fence(__ATOMIC_ACQUIRE, "agent");
            asm volatile("s_waitcnt vmcnt(0)" ::: "memory");
        }
    }
    __syncthreads();
}

namespace pg8 {
constexpr int BM = 256, BK = 64, HALF = 128, HTB = HALF * BK * 2, STAGE_BYTES = 8 * HTB, NXCD = 8, WGM = 8;
__host__ __device__ __forceinline__ int lds_byte(int r, int c) { const int st = (r >> 4) * 2 + (c >> 5), rr = r & 15, cc = c & 31, ob = rr * 64 + cc * 2; return st * 1024 + (ob ^ (((ob >> 9) & 1) << 5)); }
__host__ __device__ __forceinline__ void stage_rc(int b, int& R, int& C) { const int st = b / 1024, sb = b % 1024, swz = sb ^ (((sb >> 9) & 1) << 5); R = (st >> 1) * 16 + swz / 64; C = (st & 1) * 32 + (swz % 64) / 2; }
__host__ __device__ __forceinline__ int perm32(int rho) { const int n = rho >> 4, i = rho & 15; return 8 * (i >> 2) + 4 * n + (i & 3); }
struct Unit { int pm, pn; };
struct Gemm { const bf16_t* A; const bf16_t* Bt; };

__device__ __forceinline__ void order_unit(int L, int nM, int nN, int& pm, int& pn) {
    const int nwg = nM * nN; int wgid = L;
    { const int q = nwg / NXCD, r = nwg % NXCD, xcd = wgid % NXCD, off = wgid / NXCD; wgid = (xcd < r ? xcd * (q + 1) : r * (q + 1) + (xcd - r) * q) + off; }
    const int nig = WGM * nN, gid = wgid / nig, fm = gid * WGM, gsz = (nM - fm) < WGM ? (nM - fm) : WGM;
    pm = fm + ((wgid % nig) % gsz); pn = (wgid % nig) / gsz;
}
constexpr int NWG = 256;
template <int NM, int NN> struct StaticOrder {
    int c;
    __device__ bool next(int i, Unit& u) const { const int L = i * NWG + c; if (L >= NM * NN) return false; order_unit(L, NM, NN, u.pm, u.pn); return true; }
};

template <class Epi, class Sched, int K, int LDA, int LDB>
__device__ __forceinline__ void gemm_phase(LAS unsigned char* lds, const Gemm g, const Sched& S, const Epi& E, int tid) {
    const int wid = __builtin_amdgcn_readfirstlane(tid >> 6), lane = tid & 63, wr = wid >> 2, wc = wid & 3, fr = lane & 15, fq = lane >> 4;
    constexpr int nt = K / BK; static_assert(K % 128 == 0 && K >= 256, "K");
    unsigned voffA[2], voffB[2];
#pragma unroll
    for (int i = 0; i < 2; ++i) { int R, C; stage_rc(tid * 16 + i * 8192, R, C); const int Rb = Epi::PERM ? ((R & ~31) + perm32(R & 31)) : R;
        voffA[i] = (unsigned)(R * LDA + C) * 2u; voffB[i] = (unsigned)(Rb * LDB + C) * 2u; }
    constexpr size_t kstep = (size_t)(BK * 2);
    constexpr size_t hstepA = (size_t)HALF * LDA * 2, hstepB = (size_t)HALF * LDB * 2;
    constexpr size_t tstepA = 2 * hstepA, tstepB = 2 * hstepB;
    const unsigned ldsw = (unsigned)wid * 1024u;
    const int aoff = lds_byte(wr * 64 + fr, fq * 8), boff = lds_byte(wc * 32 + fr, fq * 8);
#define PG8_SA(b, h) (((b) * 2 + (h)) * HTB)
#define PG8_SB(b, h) ((4 + (b) * 2 + (h)) * HTB)
#define PG8_STAGE(bufoff, gbase, voff) do { _Pragma("unroll") for (int _i = 0; _i < 2; ++_i) \
        __builtin_amdgcn_global_load_lds((const unsigned*)((const char*)(gbase) + (voff)[_i]), (LAS unsigned*)(lds + (bufoff) + ldsw + _i * 8192), 16, 0, 0); } while (0)
#define PG8_LDA(dst, b, h) do { _Pragma("unroll") for (int m = 0; m < 4; ++m) _Pragma("unroll") for (int k = 0; k < 2; ++k) dst[m][k] = *(const LAS bf16x8*)(lds + PG8_SA(b, h) + aoff + m * 2048 + k * 1024); } while (0)
#define PG8_LDB(dst, b, h) do { _Pragma("unroll") for (int n = 0; n < 2; ++n) _Pragma("unroll") for (int k = 0; k < 2; ++k) dst[n][k] = *(const LAS bf16x8*)(lds + PG8_SB(b, h) + boff + n * 2048 + k * 1024); } while (0)
#define PG8_MMA(ai, bj, At, Bt) do { __builtin_amdgcn_s_setprio(1); _Pragma("unroll") for (int m = 0; m < 4; ++m) _Pragma("unroll") for (int n = 0; n < 2; ++n) _Pragma("unroll") for (int k = 0; k < 2; ++k) \
        acc[ai][bj][m][n] = __builtin_amdgcn_mfma_f32_16x16x32_bf16(Bt[n][k], At[m][k], acc[ai][bj][m][n], 0, 0, 0); __builtin_amdgcn_s_setprio(0); } while (0)
#define PG8_WAIT_V(n) asm volatile("s_waitcnt vmcnt(" #n ")" ::: "memory")
#define PG8_WAIT_L(n) asm volatile("s_waitcnt lgkmcnt(" #n ")" ::: "memory")
#define PG8_BAR __builtin_amdgcn_s_barrier()
#define PG8_SCHED __builtin_amdgcn_sched_barrier(0)
    Unit cur, nxt; int ui = 0;
    if (!S.next(0, cur)) return;
    f32x4 acc[2][2][4][2];
#pragma unroll
    for (int a = 0; a < 2; ++a)
#pragma unroll
        for (int b = 0; b < 2; ++b)
#pragma unroll
            for (int m = 0; m < 4; ++m)
#pragma unroll
                for (int n = 0; n < 2; ++n) acc[a][b][m][n] = (f32x4){0.f, 0.f, 0.f, 0.f};
    bf16x8 At[4][2], B0[2][2], B1[2][2];
    const char* cA = (const char*)g.A + (size_t)cur.pm * tstepA; const char* cB = (const char*)g.Bt + (size_t)cur.pn * tstepB;
    PG8_STAGE(PG8_SB(0, 0), cB, voffB); PG8_STAGE(PG8_SB(0, 1), cB + hstepB, voffB); PG8_STAGE(PG8_SA(0, 0), cA, voffA); PG8_STAGE(PG8_SA(0, 1), cA + hstepA, voffA);
    if (wr == 1) PG8_BAR;
    PG8_WAIT_V(2); PG8_BAR;
    PG8_STAGE(PG8_SB(1, 0), cB + kstep, voffB); PG8_STAGE(PG8_SA(1, 0), cA + kstep, voffA); PG8_STAGE(PG8_SB(1, 1), cB + hstepB + kstep, voffB);
    PG8_WAIT_V(6); PG8_BAR;
    for (;;) {
        const bool has_next = S.next(ui + 1, nxt);
        const char* nA = has_next ? (const char*)g.A + (size_t)nxt.pm * tstepA : cA; const char* nB = has_next ? (const char*)g.Bt + (size_t)nxt.pn * tstepB : cB;
        for (int t = 0; t < nt; t += 2) {
            const bool last = (t == nt - 2);
            const char* a1 = cA + (size_t)(t + 1) * kstep;
            const char* a2 = last ? nA : cA + (size_t)(t + 2) * kstep; const char* b2 = last ? nB : cB + (size_t)(t + 2) * kstep;
            const char* a3 = a2 + kstep; const char* b3 = b2 + kstep;
            PG8_LDB(B0, 0, 0); PG8_LDB(B1, 0, 1); PG8_SCHED; PG8_LDA(At, 0, 0); PG8_STAGE(PG8_SA(1, 1), a1 + hstepA, voffA);
            PG8_WAIT_V(8); PG8_WAIT_L(0); PG8_BAR; PG8_MMA(0, 0, At, B0); PG8_MMA(0, 1, At, B1); PG8_BAR; PG8_SCHED;
            PG8_LDA(At, 0, 1); PG8_STAGE(PG8_SB(0, 0), b2, voffB); PG8_STAGE(PG8_SB(0, 1), b2 + hstepB, voffB); PG8_STAGE(PG8_SA(0, 0), a2, voffA);
            PG8_WAIT_V(8); PG8_WAIT_L(0); PG8_BAR; PG8_MMA(1, 0, At, B0); PG8_MMA(1, 1, At, B1); PG8_BAR; PG8_SCHED;
            PG8_LDB(B0, 1, 0); PG8_LDB(B1, 1, 1); PG8_SCHED; PG8_LDA(At, 1, 0); PG8_STAGE(PG8_SA(0, 1), a2 + hstepA, voffA);
            PG8_WAIT_V(8); PG8_WAIT_L(0); PG8_BAR; PG8_MMA(0, 0, At, B0); PG8_MMA(0, 1, At, B1); PG8_BAR; PG8_SCHED;
            PG8_LDA(At, 1, 1); PG8_STAGE(PG8_SB(1, 0), b3, voffB); PG8_STAGE(PG8_SB(1, 1), b3 + hstepB, voffB); PG8_STAGE(PG8_SA(1, 0), a3, voffA);
            PG8_WAIT_V(8); PG8_WAIT_L(0); PG8_BAR; PG8_MMA(1, 0, At, B0); PG8_MMA(1, 1, At, B1); PG8_BAR; PG8_SCHED;
        }
        if (wr == 0) PG8_BAR;
        E(acc, cur, wr, wc, fr, fq);
        if (!has_next) break;
#pragma unroll
        for (int a = 0; a < 2; ++a)
#pragma unroll
            for (int b = 0; b < 2; ++b)
#pragma unroll
                for (int m = 0; m < 4; ++m)
#pragma unroll
                    for (int n = 0; n < 2; ++n) acc[a][b][m][n] = (f32x4){0.f, 0.f, 0.f, 0.f};
        cur = nxt; cA = nA; cB = nB; ++ui;
        if (wr == 1) PG8_BAR;
    }
    PG8_WAIT_V(0);
    PG8_BAR;
#undef PG8_SA
#undef PG8_SB
#undef PG8_STAGE
#undef PG8_LDA
#undef PG8_LDB
#undef PG8_MMA
#undef PG8_WAIT_V
#undef PG8_WAIT_L
#undef PG8_BAR
#undef PG8_SCHED
}

template <int ldc, int pn_mod> struct EpiStore {
    static constexpr bool PERM = true;
    bf16_t* O; int row_add;
    __device__ __forceinline__ void operator()(const f32x4 (&acc)[2][2][4][2], const Unit& u, int wr, int wc, int fr, int fq) const {
        const int row0 = u.pm * BM + row_add + wr * 64 + fr, col0 = (u.pn % pn_mod) * BM + wc * 32 + 8 * fq;
#pragma unroll
        for (int ai = 0; ai < 2; ++ai)
#pragma unroll
            for (int m = 0; m < 4; ++m) { bf16_t* rowp = O + (size_t)(row0 + ai * HALF + m * 16) * ldc + col0;
#pragma unroll
                for (int bj = 0; bj < 2; ++bj) { const f32x4 v0 = acc[ai][bj][m][0], v1 = acc[ai][bj][m][1];
                    u32x4 w; w.x = cvt_pk_bf16(v0[0], v0[1]); w.y = cvt_pk_bf16(v0[2], v0[3]); w.z = cvt_pk_bf16(v1[0], v1[1]); w.w = cvt_pk_bf16(v1[2], v1[3]);
                    *(u32x4*)(rowp + bj * HALF) = w; } }
    }
};
struct EpiSwiGLU {
    static constexpr bool PERM = true; static constexpr int ldc = DFF;
    bf16_t* H; int row_add;
    __device__ __forceinline__ void operator()(const f32x4 (&acc)[2][2][4][2], const Unit& u, int wr, int wc, int fr, int fq) const {
        const int row0 = u.pm * BM + row_add + wr * 64 + fr, col0 = (u.pn % 22) * HALF + wc * 32 + 8 * fq;
#pragma unroll
        for (int ai = 0; ai < 2; ++ai)
#pragma unroll
            for (int m = 0; m < 4; ++m) { bf16_t* rowp = H + (size_t)(row0 + ai * HALF + m * 16) * ldc + col0;
                float h[8];
#pragma unroll
                for (int n = 0; n < 2; ++n)
#pragma unroll
                    for (int e = 0; e < 4; ++e) { const float gt = acc[ai][0][m][n][e], up = acc[ai][1][m][n][e]; h[n * 4 + e] = siluf_(gt) * up; }
                u32x4 w; w.x = cvt_pk_bf16(h[0], h[1]); w.y = cvt_pk_bf16(h[2], h[3]); w.z = cvt_pk_bf16(h[4], h[5]); w.w = cvt_pk_bf16(h[6], h[7]);
                *(u32x4*)rowp = w; }
    }
};
struct EpiSsmState {
    static constexpr bool PERM = true;
    float* S;
    __device__ __forceinline__ void operator()(const f32x4 (&acc)[2][2][4][2], const Unit& u, int wr, int wc, int fr, int fq) const {
        const int g = u.pm >> 2; const int row0 = u.pm * BM + wr * 64 + fr, col0 = wc * 32 + 8 * fq;
#pragma unroll
        for (int ai = 0; ai < 2; ++ai)
#pragma unroll
            for (int m = 0; m < 4; ++m) { float* rowp = S + (size_t)(row0 + ai * HALF + m * 16) * 128 + col0;
                const f32x4 v0 = (g & 1) ? acc[ai][1][m][0] : acc[ai][0][m][0], v1 = (g & 1) ? acc[ai][1][m][1] : acc[ai][0][m][1];
                *(f32x4*)rowp = v0; *(f32x4*)(rowp + 4) = v1; }
    }
};
struct EpiSsmY {
    static constexpr bool PERM = true;
    bf16_t* Y;
    __device__ __forceinline__ void operator()(const f32x4 (&acc)[2][2][4][2], const Unit& u, int wr, int wc, int fr, int fq) const {
        const int g = u.pm >> 2, i = u.pm & 3, j = u.pn & 1;
#pragma unroll
        for (int ai = 0; ai < 2; ++ai)
#pragma unroll
            for (int m = 0; m < 4; ++m) { const int R = i * BM + ai * HALF + wr * 64 + m * 16 + fr; const int bb = R >> 7, cch = R & 127;
#pragma unroll
                for (int bj = 0; bj < 2; ++bj) { const int cc = j * BM + bj * HALF + wc * 32 + 8 * fq; const int tk = cc >> 4, ch = cc & 15;
                    const size_t tok = (size_t)bb * SEQ + cch * SSM_T + tk;
                    const f32x4 v0 = acc[ai][bj][m][0], v1 = acc[ai][bj][m][1];
                    u32x4 w; w.x = cvt_pk_bf16(gelu_tanh(v0[0]), gelu_tanh(v0[1])); w.y = cvt_pk_bf16(gelu_tanh(v0[2]), gelu_tanh(v0[3]));
                    w.z = cvt_pk_bf16(gelu_tanh(v1[0]), gelu_tanh(v1[1])); w.w = cvt_pk_bf16(gelu_tanh(v1[2]), gelu_tanh(v1[3]));
                    *(u32x4*)(Y + tok * 512 + g * 16 + ch) = w; } }
    }
};
struct EpiGlu {
    static constexpr bool PERM = true;
    const bf16_t* Yin; bf16_t* O;
    __device__ __forceinline__ void operator()(const f32x4 (&acc)[2][2][4][2], const Unit& u, int wr, int wc, int fr, int fq) const {
        const int row0 = u.pm * BM + wr * 64 + fr, col0 = u.pn * BM + wc * 32 + 8 * fq;
#pragma unroll
        for (int ai = 0; ai < 2; ++ai)
#pragma unroll
            for (int m = 0; m < 4; ++m) { const size_t row = (size_t)(row0 + ai * HALF + m * 16);
#pragma unroll
                for (int bj = 0; bj < 2; ++bj) { const int col = col0 + bj * HALF; const u32x4 yv = *(const u32x4*)(Yin + row * 512 + col);
                    const f32x4 v0 = acc[ai][bj][m][0], v1 = acc[ai][bj][m][1];
                    u32x4 w; w.x = cvt_pk_bf16(bflo(yv.x) * sigmoidf_(v0[0]), bfhi(yv.x) * sigmoidf_(v0[1])); w.y = cvt_pk_bf16(bflo(yv.y) * sigmoidf_(v0[2]), bfhi(yv.y) * sigmoidf_(v0[3]));
                    w.z = cvt_pk_bf16(bflo(yv.z) * sigmoidf_(v1[0]), bfhi(yv.z) * sigmoidf_(v1[1])); w.w = cvt_pk_bf16(bflo(yv.w) * sigmoidf_(v1[2]), bfhi(yv.w) * sigmoidf_(v1[3]));
                    *(u32x4*)(O + row * 1024 + 512 + col) = w; } }
    }
};
struct SsmYOrder {
    int c;
    __device__ bool next(int i, Unit& u) const { const int L = i * NWG + c; if (L >= 256) return false; const int x = L & 7, y = L >> 3, g = x * 4 + (y >> 3), s = y & 7; u.pm = 4 * g + (s >> 1); u.pn = 2 * g + (s & 1); return true; }
};
struct SsmStateOrder {
    int c;
    __device__ bool next(int i, Unit& u) const { const int L = i * NWG + c; if (L >= 128) return false; const int g = L >> 2; u.pm = L; u.pn = g >> 1; return true; }
};
template <int nN> struct MoeOrder {
    int nM, c, c0, pm_out_add; int t1, t2, t3, t4, t5, t6, t7;
    __device__ bool next(int i, Unit& u) const {
        const int L = i * NWG + c; if (L >= nM * nN) return false;
        int pml, pnl; order_unit(L, nM, nN, pml, pnl); const int pg = c0 + pml;
        const int e = (pg >= t1) + (pg >= t2) + (pg >= t3) + (pg >= t4) + (pg >= t5) + (pg >= t6) + (pg >= t7);
        u.pm = pml + pm_out_add; u.pn = e * nN + pnl; return true;
    }
};
}

__device__ __forceinline__ void transpose_item(const float* Wsrc, int ldw, bf16_t* dst, int ldd, LAS float* scr, int lane) {
#pragma unroll 8
    for (int i = 0; i < 32; ++i) { const int kk = 2 * i + (lane >> 5); scr[kk * 33 + (lane & 31)] = Wsrc[(size_t)kk * ldw + (lane & 31)]; }
    LDS_WAIT(); asm volatile("" ::: "memory");
    const int c = lane & 7;
#pragma unroll
    for (int j = 0; j < 4; ++j) { const int n = (lane >> 3) + 8 * j; const LAS float* s = scr + (8 * c) * 33 + n;
        u32x4 o; o.x = pk2(s[0 * 33], s[1 * 33]); o.y = pk2(s[2 * 33], s[3 * 33]); o.z = pk2(s[4 * 33], s[5 * 33]); o.w = pk2(s[6 * 33], s[7 * 33]);
        *(u32x4*)(dst + (size_t)n * ldd + 8 * c) = o; }
    LDS_WAIT(); asm volatile("" ::: "memory");
}
__device__ __forceinline__ void tr_plain(const float* W, int K, int N, bf16_t* WT, int item, LAS float* scr, int lane) {
    const int nblk = N / 32, kb = item / nblk, nb = item % nblk;
    transpose_item(W + (size_t)(64 * kb) * N + 32 * nb, N, WT + (size_t)(32 * nb) * K + 64 * kb, K, scr, lane);
}
__device__ __forceinline__ void tr_win(const float* W, bf16_t* WT, int item, LAS float* scr, int lane) {
    const int kb = item / 56, nb = item % 56; const int nsrc = nb < 40 ? 32 * nb : 1304 + 32 * (nb - 40);
    transpose_item(W + (size_t)(64 * kb) * PWID + nsrc, PWID, WT + (size_t)(32 * nb) * 1024 + 64 * kb, 1024, scr, lane);
}
__device__ __forceinline__ void tr_gu(const float* W, int up, bf16_t* WT, int item, LAS float* scr, int lane) {
    const int kb = item / 88, nb = item % 88; const int n0 = 32 * nb; const int drow = (n0 >> 7) * 256 + (n0 & 127) + (up ? 128 : 0);
    transpose_item(W + (size_t)(64 * kb) * DFF + n0, DFF, WT + (size_t)drow * 1024 + 64 * kb, 1024, scr, lane);
}

struct Ptrs {
    const float* in[32]; float* out; unsigned char* ws; int ph_lo, ph_hi;
};
enum { I_X = 0, I_C, I_WIN, I_POSK, I_POSV, I_W1K, I_W2K, I_W1V, I_W2V, I_ARE, I_AIM, I_LDT, I_BRE, I_BIM, I_CRE, I_CIM, I_SD, I_WGLU, I_NA, I_NS, I_WOUT, I_ADAW, I_ADAB, I_LNG, I_LNB,
       I_FG, I_FU, I_FD, I_ROUTER, I_MG, I_MU, I_MD };

__device__ __forceinline__ void p0_prologue(const Ptrs& P, LAS unsigned char* lds, int vcu, int G, int tid, int lane, int wave) {
    float* MOD = (float*)(P.ws + WS_MOD); float* MISC = (float*)(P.ws + WS_MISC);
    for (int it = vcu; it < 200; it += G) {
        __syncthreads();
        if (it < 192) {
            const int l = it / 48, jb = it % 48;
            LAS float* cact = (LAS float*)lds; LAS float* red = (LAS float*)(lds + 32768);
            for (int i = tid; i < NB * DM; i += NTHREADS) cact[i] = siluf_(P.in[I_C][i]);
            __syncthreads();
            const int jl = tid & 127, kq = tid >> 7;
            const float* w = P.in[I_ADAW] + (size_t)l * DM * 6144 + (size_t)(kq * 256) * 6144 + jb * 128 + jl;
            float acc[8];
#pragma unroll
            for (int b = 0; b < 8; ++b) acc[b] = 0.f;
#pragma unroll 4
            for (int k = 0; k < 256; ++k) { const float wv = w[(size_t)k * 6144];
#pragma unroll
                for (int b = 0; b < 8; ++b) acc[b] += cact[b * DM + kq * 256 + k] * wv; }
#pragma unroll
            for (int b = 0; b < 8; ++b) red[(kq * 8 + b) * 128 + jl] = acc[b];
            __syncthreads();
            for (int o = tid; o < 8 * 128; o += NTHREADS) { const int b = o >> 7, j = o & 127;
                const float s = (red[(0 * 8 + b) * 128 + j] + red[(1 * 8 + b) * 128 + j]) + (red[(2 * 8 + b) * 128 + j] + red[(3 * 8 + b) * 128 + j]);
                MOD[((size_t)l * 8 + b) * 6144 + jb * 128 + j] = s + P.in[I_ADAB][l * 6144 + jb * 128 + j]; }
        } else {
            const int q = it - 192, l = q >> 1, kv = q & 1;
            const float* pos = (kv ? P.in[I_POSV] : P.in[I_POSK]) + (size_t)l * 2048; const float* w1 = (kv ? P.in[I_W1V] : P.in[I_W1K]) + (size_t)l * 2048 * 64;
            LAS float* red = (LAS float*)lds;
            const int f = tid & 63, part = tid >> 6; float acc = 0.f;
            for (int k = part * 256; k < part * 256 + 256; ++k) acc += pos[k] * w1[(size_t)k * 64 + f];
            red[part * 64 + f] = acc;
            __syncthreads();
            if (tid < 64) { float s = 0.f;
#pragma unroll
                for (int p = 0; p < 8; ++p) s += red[p * 64 + tid];
                MISC[MS_CMPB + (l * 2 + kv) * 64 + tid] = s; }
        }
    }
    __syncthreads();
    LAS float* scr = (LAS float*)(lds + wave * 16384);
    const int gw = vcu * NWAVES + wave, NGW = G * NWAVES;
    constexpr int I_IN = 16 * 56, I_OUT = 16 * 32, I_GLU = 8 * 16, I_GU = 16 * 88, I_DN = 44 * 32;
    constexpr int N1 = 4 * I_IN, N2 = N1 + 4 * I_OUT, N3 = N2 + 4 * I_GLU, N4 = N3 + 4 * I_GU, N5 = N4 + 2 * I_DN;
    for (int it = gw; it < N5; it += NGW) {
        if (it < N1) { const int l = it / I_IN, r = it % I_IN; tr_win(P.in[I_WIN] + (size_t)l * DM * PWID, (bf16_t*)(P.ws + WS_WIN) + (size_t)l * NPROJ * DM, r, scr, lane); }
        else if (it < N2) { const int q = it - N1, l = q / I_OUT, r = q % I_OUT; tr_plain(P.in[I_WOUT] + (size_t)l * DM * DM, DM, DM, (bf16_t*)(P.ws + WS_WOUT) + (size_t)l * DM * DM, r, scr, lane); }
        else if (it < N3) { const int q = it - N2, l = q / I_GLU, r = q % I_GLU; tr_plain(P.in[I_WGLU] + (size_t)l * 512 * 512, 512, 512, (bf16_t*)(P.ws + WS_WGLU) + (size_t)l * 512 * 512, r, scr, lane); }
        else if (it < N4) { const int q = it - N3, s = q / I_GU, r = q % I_GU; const int i = s >> 1, up = s & 1;
            tr_gu((up ? P.in[I_FU] : P.in[I_FG]) + (size_t)i * DM * DFF, up, (bf16_t*)(P.ws + WS_FGU) + (size_t)i * 5632 * DM, r, scr, lane); }
        else { const int q = it - N4, i = q / I_DN, r = q % I_DN; tr_plain(P.in[I_FD] + (size_t)i * DFF * DM, DFF, DM, (bf16_t*)(P.ws + WS_FD) + (size_t)i * DM * DFF, r, scr, lane); }
    }
}

__device__ __forceinline__ void prep_layer(const Ptrs& P, int l, LAS unsigned char* lds, int vcu, int G, int tid, int lane, int wave) {
    float* MISC = (float*)(P.ws + WS_MISC);
    for (int g = vcu; g < SSM_G; g += G) {
        __syncthreads();
        LAS f32x2* Cc = (LAS f32x2*)lds;
        LAS f32x2* Bb = (LAS f32x2*)(lds + 8192);
        LAS f32x2* Pw = (LAS f32x2*)(lds + 16384);
        LAS float* Kt = (LAS float*)(lds + 16384 + 16896);
        LAS float* Dd = (LAS float*)(lds + 16384 + 16896 + 32768);
        const size_t gp = (size_t)l * SSM_G + g;
        for (int i = tid; i < 1024; i += NTHREADS) Cc[i] = (f32x2){P.in[I_CRE][gp * 1024 + i], P.in[I_CIM][gp * 1024 + i]};
        if (tid < 16) Dd[tid] = P.in[I_SD][gp * 16 + tid];
        if (tid < 64) {
            const int p = tid; const float are = P.in[I_ARE][gp * 64 + p], aim = P.in[I_AIM][gp * 64 + p], dt = __expf(P.in[I_LDT][gp]);
            const float mag = __expf(are * dt); float ang = aim * dt * 0.15915494309189535f; ang -= floorf(ang + 0.5f);
            const float abr = mag * __builtin_amdgcn_cosf(ang), abi = mag * __builtin_amdgcn_sinf(ang);
            const float nr = abr - 1.0f, ni = abi, den = 1.0f / (are * are + aim * aim);
            const float cr = (nr * are + ni * aim) * den, ci = (ni * are - nr * aim) * den;
            float pr = 1.f, pi = 0.f;
            for (int t = 0; t <= 32; ++t) { Pw[p * 33 + t] = (f32x2){pr, pi}; const float nr2 = pr * abr - pi * abi, ni2 = pr * abi + pi * abr; pr = nr2; pi = ni2; }
            MISC[MS_A32 + (g * 64 + p) * 2 + 0] = Pw[p * 33 + 32].x; MISC[MS_A32 + (g * 64 + p) * 2 + 1] = Pw[p * 33 + 32].y;
            for (int h = 0; h < 16; ++h) { const float br = P.in[I_BRE][(gp * 64 + p) * 16 + h], bi = P.in[I_BIM][(gp * 64 + p) * 16 + h];
                Bb[p * 16 + h] = (f32x2){cr * br - ci * bi, cr * bi + ci * br}; }
        }
        __syncthreads();
        for (int idx = tid; idx < 32 * 256; idx += NTHREADS) { const int tau = idx >> 8, hp = (idx >> 4) & 15, h = idx & 15; float s = 0.f;
            for (int p = 0; p < 64; ++p) { const f32x2 c = Cc[hp * 64 + p], w = Pw[p * 33 + tau], b = Bb[p * 16 + h];
                const float zr = c.x * w.x - c.y * w.y, zi = c.x * w.y + c.y * w.x; s += zr * b.x - zi * b.y; }
            Kt[idx] = s; }
        __syncthreads();
        bf16_t* Mt = (bf16_t*)(P.ws + WS_SSMM) + (size_t)g * 512 * SSM_K;
        for (int q = tid; q < 512 * 80; q += NTHREADS) { const int n = q / 80, ch = q % 80; const int i = n >> 4, hp = n & 15; float v[8];
            if (ch < 64) { const int j = ch >> 1, h0 = (ch & 1) * 8;
                if (j <= i) {
#pragma unroll
                    for (int e = 0; e < 8; ++e) v[e] = Kt[(i - j) * 256 + hp * 16 + h0 + e];
                    if (j == i) {
#pragma unroll
                        for (int e = 0; e < 8; ++e) if (h0 + e == hp) v[e] += Dd[hp];
                    }
                } else {
#pragma unroll
                    for (int e = 0; e < 8; ++e) v[e] = 0.f;
                }
            } else { const int p0 = (ch - 64) * 4;
#pragma unroll
                for (int e = 0; e < 4; ++e) { const f32x2 c = Cc[hp * 64 + p0 + e], w = Pw[(p0 + e) * 33 + i + 1];
                    v[2 * e] = c.x * w.x - c.y * w.y; v[2 * e + 1] = -(c.x * w.y + c.y * w.x); }
            }
            u32x4 o; o.x = pk2(v[0], v[1]); o.y = pk2(v[2], v[3]); o.z = pk2(v[4], v[5]); o.w = pk2(v[6], v[7]);
            *(u32x4*)(Mt + (size_t)n * SSM_K + ch * 8) = o; }
        bf16_t* Et = (bf16_t*)(P.ws + WS_SSME) + (size_t)g * 128 * 512;
        for (int q = tid; q < 128 * 64; q += NTHREADS) { const int n = q >> 6, ch = q & 63; const int p = n >> 1, ri = n & 1, j = ch >> 1, h0 = (ch & 1) * 8; float v[8];
            const f32x2 w = Pw[p * 33 + 31 - j];
#pragma unroll
            for (int e = 0; e < 8; ++e) { const f32x2 b = Bb[p * 16 + h0 + e]; v[e] = ri ? (w.x * b.y + w.y * b.x) : (w.x * b.x - w.y * b.y); }
            u32x4 o; o.x = pk2(v[0], v[1]); o.y = pk2(v[2], v[3]); o.z = pk2(v[4], v[5]); o.w = pk2(v[6], v[7]);
            *(u32x4*)(Et + (size_t)n * 512 + ch * 8) = o; }
    }
    __syncthreads();
    if (l & 1) {
        const int ml = l >> 1;
        LAS float* scr = (LAS float*)(lds + wave * 16384);
        const int gw = vcu * NWAVES + wave, NGW = G * NWAVES;
        constexpr int I_GU = 16 * 88, I_DN = 44 * 32; constexpr int N1 = 16 * I_GU, N2 = N1 + 8 * I_DN;
        for (int it = gw; it < N2; it += NGW) {
            if (it < N1) { const int s = it / I_GU, r = it % I_GU; const int e = s >> 1, up = s & 1;
                tr_gu((up ? P.in[I_MU] : P.in[I_MG]) + ((size_t)ml * NEXP + e) * DM * DFF, up, (bf16_t*)(P.ws + WS_MGU) + (size_t)e * 5632 * DM, r, scr, lane); }
            else { const int q = it - N1, e = q / I_DN, r = q % I_DN;
                tr_plain(P.in[I_MD] + ((size_t)ml * NEXP + e) * DFF * DM, DFF, DM, (bf16_t*)(P.ws + WS_MD) + (size_t)e * DM * DFF, r, scr, lane); }
        }
    }
}

struct MoeOff { int t0, t1, t2, t3, t4, t5, t6, t7, t8; };
__device__ __forceinline__ MoeOff load_moe_off(const unsigned char* ws, int ml) {
    const unsigned* c = (const unsigned*)(ws + WS_CTL) + CW_MOE + 64 * 8 * ml; MoeOff o; int a = 0;
    o.t0 = a; a += (int)((__hip_atomic_load(c + 64 * 0, __ATOMIC_RELAXED, __HIP_MEMORY_SCOPE_AGENT) + 255u) >> 8);
    o.t1 = a; a += (int)((__hip_atomic_load(c + 64 * 1, __ATOMIC_RELAXED, __HIP_MEMORY_SCOPE_AGENT) + 255u) >> 8);
    o.t2 = a; a += (int)((__hip_atomic_load(c + 64 * 2, __ATOMIC_RELAXED, __HIP_MEMORY_SCOPE_AGENT) + 255u) >> 8);
    o.t3 = a; a += (int)((__hip_atomic_load(c + 64 * 3, __ATOMIC_RELAXED, __HIP_MEMORY_SCOPE_AGENT) + 255u) >> 8);
    o.t4 = a; a += (int)((__hip_atomic_load(c + 64 * 4, __ATOMIC_RELAXED, __HIP_MEMORY_SCOPE_AGENT) + 255u) >> 8);
    o.t5 = a; a += (int)((__hip_atomic_load(c + 64 * 5, __ATOMIC_RELAXED, __HIP_MEMORY_SCOPE_AGENT) + 255u) >> 8);
    o.t6 = a; a += (int)((__hip_atomic_load(c + 64 * 6, __ATOMIC_RELAXED, __HIP_MEMORY_SCOPE_AGENT) + 255u) >> 8);
    o.t7 = a; a += (int)((__hip_atomic_load(c + 64 * 7, __ATOMIC_RELAXED, __HIP_MEMORY_SCOPE_AGENT) + 255u) >> 8);
    o.t8 = a; return o;
}
__device__ __forceinline__ int moe_tile_of(const MoeOff& o, int e) { return e == 0 ? o.t0 : e == 1 ? o.t1 : e == 2 ? o.t2 : e == 3 ? o.t3 : e == 4 ? o.t4 : e == 5 ? o.t5 : e == 6 ? o.t6 : o.t7; }

template <int SRC, int EXTRA, bool HM>
__device__ __forceinline__ void row_pass(const Ptrs& P, LAS unsigned char* lds, int vcu, int G, int tid, int lane, int wave,
                                         const float* gv, const float* lng, const float* lnb, const float* sc, const float* sh,
                                         const float* wx  , int ml) {
    float* X = P.out; const bf16_t* Y = (const bf16_t*)(P.ws + WS_YO); bf16_t* HMo = (bf16_t*)(P.ws + WS_HM);
    LAS float* wl = (LAS float*)lds;
    LAS int* lcnt = (LAS int*)(lds + 98304); LAS int* lbase = lcnt + 8; LAS int* rec = (LAS int*)(lds + 98304 + 64);
    __syncthreads();
    if (EXTRA == 1) { for (int i = tid; i < 24 * 1024; i += NTHREADS) { const int c = i >> 10, k = i & 1023; wl[i] = wx[(size_t)k * PWID + c]; } }
    if (EXTRA == 2) { for (int i = tid; i < 8 * 1024; i += NTHREADS) { const int e = i >> 10, k = i & 1023; wl[i] = wx[(size_t)k * 8 + e]; } if (tid < 8) lcnt[tid] = 0; }
    __syncthreads();
    MoeOff mo; if (SRC == 2) mo = load_moe_off(P.ws, ml);
    const int rpw = MTOK / G, rpv = rpw / NWAVES;
    for (int rr = 0; rr < rpv; ++rr) {
        const int lr = wave * rpv + rr; const size_t m = (size_t)vcu * rpw + lr; const int b = (int)(m >> 12);
        f32x4 v[4];
        if (SRC == 0) {
#pragma unroll
            for (int j = 0; j < 4; ++j) v[j] = *(const f32x4*)(P.in[I_X] + m * DM + 4 * lane + 256 * j);
        } else {
            f32x4 y[4];
            if (SRC == 1) {
#pragma unroll
                for (int j = 0; j < 4; ++j) { const u32x2 w = *(const u32x2*)(Y + m * DM + 4 * lane + 256 * j); y[j] = (f32x4){bflo(w.x), bfhi(w.x), bflo(w.y), bfhi(w.y)}; }
            } else {
                const int4 rt = *(const int4*)(P.ws + WS_ROUTE + m * 16); const f32x2 rw = *(const f32x2*)(P.ws + WS_ROUTE + 524288 + m * 8);
                const size_t s0 = (size_t)moe_tile_of(mo, rt.x) * 256 + rt.y, s1 = (size_t)moe_tile_of(mo, rt.z) * 256 + rt.w;
                const bf16_t* F = (const bf16_t*)(P.ws + WS_XS);
#pragma unroll
                for (int j = 0; j < 4; ++j) { const u32x2 a = *(const u32x2*)(F + s0 * DM + 4 * lane + 256 * j), c = *(const u32x2*)(F + s1 * DM + 4 * lane + 256 * j);
                    y[j] = (f32x4){rw.x * bflo(a.x) + rw.y * bflo(c.x), rw.x * bfhi(a.x) + rw.y * bfhi(c.x), rw.x * bflo(a.y) + rw.y * bflo(c.y), rw.x * bfhi(a.y) + rw.y * bfhi(c.y)}; }
            }
            float s = 0.f;
#pragma unroll
            for (int j = 0; j < 4; ++j) { const f32x4 xv = *(const f32x4*)(X + m * DM + 4 * lane + 256 * j); const f32x4 g1 = *(const f32x4*)(gv + (size_t)b * 6144 + 4 * lane + 256 * j);
                v[j] = DN_ALPHA * xv + (1.0f + g1) * y[j]; s += (v[j].x + v[j].y) + (v[j].z + v[j].w); }
            const float mean = wave_sum(s) * (1.f / DM); float s2 = 0.f;
#pragma unroll
            for (int j = 0; j < 4; ++j) { v[j] = v[j] - mean; s2 += (v[j].x * v[j].x + v[j].y * v[j].y) + (v[j].z * v[j].z + v[j].w * v[j].w); }
            const float rstd = 1.0f / sqrtf(wave_sum(s2) * (1.f / DM) + LN_EPS);
#pragma unroll
            for (int j = 0; j < 4; ++j) { const f32x4 gg = *(const f32x4*)(lng + 4 * lane + 256 * j), bb = *(const f32x4*)(lnb + 4 * lane + 256 * j); v[j] = v[j] * rstd * gg + bb; }
        }
#pragma unroll
        for (int j = 0; j < 4; ++j) *(f32x4*)(X + m * DM + 4 * lane + 256 * j) = v[j];
        if (HM) {
#pragma unroll
            for (int j = 0; j < 4; ++j) { const f32x4 s1 = *(const f32x4*)(sc + (size_t)b * 6144 + 4 * lane + 256 * j), h1 = *(const f32x4*)(sh + (size_t)b * 6144 + 4 * lane + 256 * j);
                v[j] = v[j] * (1.0f + s1) + h1;
                u32x2 w; w.x = pk2(v[j].x, v[j].y); w.y = pk2(v[j].z, v[j].w); *(u32x2*)(HMo + m * DM + 4 * lane + 256 * j) = w; }
            if (EXTRA == 1) {
                float mine = 0.f;
#pragma unroll 1
                for (int c = 0; c < 24; ++c) { float s = 0.f;
#pragma unroll
                    for (int j = 0; j < 4; ++j) { const f32x4 w = *(const LAS f32x4*)(wl + c * 1024 + 4 * lane + 256 * j); s += (v[j].x * w.x + v[j].y * w.y) + (v[j].z * w.z + v[j].w * w.w); }
                    s = wave_sum(s); if (lane == c) mine = s; }
                if (lane < 24) ((float*)(P.ws + WS_GATE))[m * 24 + lane] = sigmoidf_(mine);
            }
            if (EXTRA == 2) {
                float lg[8];
#pragma unroll
                for (int e = 0; e < 8; ++e) { float s = 0.f;
#pragma unroll
                    for (int j = 0; j < 4; ++j) { const f32x4 w = *(const LAS f32x4*)(wl + e * 1024 + 4 * lane + 256 * j); s += (v[j].x * w.x + v[j].y * w.y) + (v[j].z * w.z + v[j].w * w.w); }
                    lg[e] = wave_sum(s); }
                int e0 = 0; float v0 = lg[0];
#pragma unroll
                for (int e = 1; e < 8; ++e) if (lg[e] > v0) { v0 = lg[e]; e0 = e; }
                int e1 = -1; float v1 = -3.0e38f;
#pragma unroll
                for (int e = 0; e < 8; ++e) if (e != e0 && lg[e] > v1) { v1 = lg[e]; e1 = e; }
                const float ex = fast_exp(v1 - v0), w0 = 1.0f / (1.0f + ex), w1 = ex * w0;
                if (lane == 0) { const int r0 = __hip_atomic_fetch_add(lcnt + e0, 1, __ATOMIC_RELAXED, __HIP_MEMORY_SCOPE_WORKGROUP), r1 = __hip_atomic_fetch_add(lcnt + e1, 1, __ATOMIC_RELAXED, __HIP_MEMORY_SCOPE_WORKGROUP);
                    rec[lr * 4 + 0] = e0; rec[lr * 4 + 1] = r0; rec[lr * 4 + 2] = e1; rec[lr * 4 + 3] = r1;
                    *(f32x2*)(P.ws + WS_ROUTE + 524288 + m * 8) = (f32x2){w0, w1}; }
            }
        }
    }
    if (EXTRA == 2) {
        __syncthreads();
        if (tid < 8) lbase[tid] = (int)__hip_atomic_fetch_add((unsigned*)(P.ws + WS_CTL) + CW_MOE + 64 * (8 * ml + tid), (unsigned)lcnt[tid], __ATOMIC_RELAXED, __HIP_MEMORY_SCOPE_AGENT);
        __syncthreads();
        if (tid < rpw) { const size_t m = (size_t)vcu * rpw + tid; const int e0 = rec[tid * 4 + 0], e1 = rec[tid * 4 + 2];
            *(int4*)(P.ws + WS_ROUTE + m * 16) = make_int4(e0, lbase[e0] + rec[tid * 4 + 1], e1, lbase[e1] + rec[tid * 4 + 3]); }
    }
}

__device__ __forceinline__ void moe_dispatch(const Ptrs& P, int ml, int vcu, int G, int lane, int wave) {
    const MoeOff mo = load_moe_off(P.ws, ml);
    const bf16_t* HMi = (const bf16_t*)(P.ws + WS_HM); bf16_t* XS = (bf16_t*)(P.ws + WS_XS);
    for (size_t m = (size_t)vcu * NWAVES + wave; m < MTOK; m += (size_t)G * NWAVES) {
        const int4 rt = *(const int4*)(P.ws + WS_ROUTE + m * 16);
        const size_t s0 = (size_t)moe_tile_of(mo, rt.x) * 256 + rt.y, s1 = (size_t)moe_tile_of(mo, rt.z) * 256 + rt.w;
        const u32x4 a = *(const u32x4*)(HMi + m * DM + 8 * lane), c = *(const u32x4*)(HMi + m * DM + 512 + 8 * lane);
        *(u32x4*)(XS + s0 * DM + 8 * lane) = a; *(u32x4*)(XS + s0 * DM + 512 + 8 * lane) = c;
        *(u32x4*)(XS + s1 * DM + 8 * lane) = a; *(u32x4*)(XS + s1 * DM + 512 + 8 * lane) = c;
    }
}

__device__ __forceinline__ void rms_pass(const Ptrs& P, int l, int vcu, int G, int lane, int wave) {
    bf16_t* O = (bf16_t*)(P.ws + WS_O); const float* ga = P.in[I_NA] + l * 512; const float* gs = P.in[I_NS] + l * 512;
    for (size_t m = (size_t)vcu * NWAVES + wave; m < MTOK; m += (size_t)G * NWAVES) {
        const u32x4 a = *(const u32x4*)(O + m * DM + 8 * lane), c = *(const u32x4*)(O + m * DM + 512 + 8 * lane);
        float fa[8] = {bflo(a.x), bfhi(a.x), bflo(a.y), bfhi(a.y), bflo(a.z), bfhi(a.z), bflo(a.w), bfhi(a.w)};
        float fc[8] = {bflo(c.x), bfhi(c.x), bflo(c.y), bfhi(c.y), bflo(c.z), bfhi(c.z), bflo(c.w), bfhi(c.w)};
        float sa = 0.f, ss = 0.f;
#pragma unroll
        for (int e = 0; e < 8; ++e) { sa += fa[e] * fa[e]; ss += fc[e] * fc[e]; }
        const float ra = 1.0f / sqrtf(wave_sum(sa) * (1.f / 512.f) + RMS_EPS), rs = 1.0f / sqrtf(wave_sum(ss) * (1.f / 512.f) + RMS_EPS);
        const f32x4 g0 = *(const f32x4*)(ga + 8 * lane), g1 = *(const f32x4*)(ga + 8 * lane + 4), h0 = *(const f32x4*)(gs + 8 * lane), h1 = *(const f32x4*)(gs + 8 * lane + 4);
        u32x4 oa, oc;
        oa.x = pk2(fa[0] * ra * g0.x, fa[1] * ra * g0.y); oa.y = pk2(fa[2] * ra * g0.z, fa[3] * ra * g0.w); oa.z = pk2(fa[4] * ra * g1.x, fa[5] * ra * g1.y); oa.w = pk2(fa[6] * ra * g1.z, fa[7] * ra * g1.w);
        oc.x = pk2(fc[0] * rs * h0.x, fc[1] * rs * h0.y); oc.y = pk2(fc[2] * rs * h0.z, fc[3] * rs * h0.w); oc.z = pk2(fc[4] * rs * h1.x, fc[5] * rs * h1.y); oc.w = pk2(fc[6] * rs * h1.z, fc[7] * rs * h1.w);
        *(u32x4*)(O + m * DM + 8 * lane) = oa; *(u32x4*)(O + m * DM + 512 + 8 * lane) = oc;
    }
}

__device__ __forceinline__ void compress_unit(const Ptrs& P, int l, int unit, LAS unsigned char* lds, int tid) {
    const int nt = unit & 7, kv = (unit >> 3) & 1, h = (unit >> 4) & 1, b = unit >> 5;
    const bf16_t* PROJ = (const bf16_t*)(P.ws + WS_PROJ);
    const int col = (kv ? COL_VC : COL_KC) + h * 64;
    const float* w1 = (kv ? P.in[I_W1V] : P.in[I_W1K]) + (size_t)l * 2048 * 64; const float* w2 = (kv ? P.in[I_W2V] : P.in[I_W2K]) + (size_t)l * 64 * 64;
    const float* bias = (const float*)(P.ws + WS_MISC) + MS_CMPB + (l * 2 + kv) * 64;
    LAS bf16_t* At = (LAS bf16_t*)lds;
    LAS float* hid = (LAS float*)(lds + 528 * 144);
    const int tok0 = 512 * nt;
    __syncthreads();
    for (int i = tid; i < 528 * 8; i += NTHREADS) { const int t = i >> 3, c = i & 7; const int tok = tok0 + t;
        u32x4 v = (u32x4){0u, 0u, 0u, 0u}; if (tok < SEQ) v = *(const u32x4*)(PROJ + ((size_t)b * SEQ + tok) * NPROJ + col + c * 8);
        *(LAS u32x4*)(At + t * 72 + c * 8) = v; }
    __syncthreads();
    const int f = tid & 63, w = tid >> 6;
    float acc[4]; { const float bb = bias[f];
#pragma unroll
        for (int i = 0; i < 4; ++i) acc[i] = bb; }
    for (int lp = 0; lp < 32; ++lp) {
#pragma unroll 2
        for (int d0 = 0; d0 < 64; d0 += 8) {
            float wv[8];
#pragma unroll
            for (int e = 0; e < 8; ++e) wv[e] = w1[(size_t)(lp * 64 + d0 + e) * 64 + f];
#pragma unroll
            for (int i = 0; i < 4; ++i) { const u32x4 a = *(const LAS u32x4*)(At + (16 * (4 * w + i) + lp) * 72 + d0);
                acc[i] += bflo(a.x) * wv[0] + bfhi(a.x) * wv[1] + bflo(a.y) * wv[2] + bfhi(a.y) * wv[3] + bflo(a.z) * wv[4] + bfhi(a.z) * wv[5] + bflo(a.w) * wv[6] + bfhi(a.w) * wv[7]; }
        }
    }
#pragma unroll
    for (int i = 0; i < 4; ++i) hid[(4 * w + i) * 64 + f] = gelu_tanh(acc[i]);
    __syncthreads();
    float o[4] = {0.f, 0.f, 0.f, 0.f};
    for (int ff = 0; ff < 64; ++ff) { const float wv = w2[ff * 64 + f];
#pragma unroll
        for (int i = 0; i < 4; ++i) o[i] += hid[(4 * w + i) * 64 + ff] * wv; }
    bf16_t* KC = (bf16_t*)(P.ws + WS_KCMP) + (size_t)(b * 2 + h) * NCMPP * 64; bf16_t* VCT = (bf16_t*)(P.ws + WS_VCMPT) + (size_t)(b * 2 + h) * 64 * NCMPP;
#pragma unroll
    for (int i = 0; i < 4; ++i) { const int n = 32 * nt + 4 * w + i; const float val = (n < NCMP) ? o[i] : 0.f;
        if (kv == 0) KC[(size_t)n * 64 + f] = (bf16_t)f2bf(val); else VCT[(size_t)f * NCMPP + n] = (bf16_t)f2bf(val); }
}
__device__ __forceinline__ void vtrans_item(const Ptrs& P, int item, LAS unsigned char* lds, int tid) {
    const int tt = item & 63, which = (item >> 6) & 1, h = (item >> 7) & 1, b = item >> 8;
    const bf16_t* PROJ = (const bf16_t*)(P.ws + WS_PROJ); const int col = (which ? COL_VW : COL_VS) + h * 64;
    bf16_t* dst = (bf16_t*)(P.ws + (which ? WS_VWT : WS_VST)) + (size_t)(b * 2 + h) * 64 * SEQ;
    LAS bf16_t* T = (LAS bf16_t*)lds;
    __syncthreads();
    { const int t = tid >> 3, c = tid & 7; const u32x4 v = *(const u32x4*)(PROJ + ((size_t)b * SEQ + tt * 64 + t) * NPROJ + col + c * 8);
      LAS unsigned* p = (LAS unsigned*)(T + t * 66 + c * 8); p[0] = v.x; p[1] = v.y; p[2] = v.z; p[3] = v.w; }
    __syncthreads();
    { const int d = tid >> 3, c = tid & 7; unsigned short e[8];
#pragma unroll
      for (int k = 0; k < 8; ++k) e[k] = T[(c * 8 + k) * 66 + d];
      u32x4 o; o.x = e[0] | ((unsigned)e[1] << 16); o.y = e[2] | ((unsigned)e[3] << 16); o.z = e[4] | ((unsigned)e[5] << 16); o.w = e[6] | ((unsigned)e[7] << 16);
      *(u32x4*)(dst + (size_t)d * SEQ + tt * 64 + c * 8) = o; }
}
__device__ __forceinline__ void ug_build(const Ptrs& P, int vcu, int G, int lane, int wave) {
    const bf16_t* PROJ = (const bf16_t*)(P.ws + WS_PROJ); bf16_t* UG = (bf16_t*)(P.ws + WS_UG);
    for (size_t m = (size_t)vcu * NWAVES + wave; m < MTOK; m += (size_t)G * NWAVES) {
        const int b = (int)(m >> 12), t = (int)(m & 4095), c = t >> 5, j = t & 31, g = lane >> 1, hh = lane & 1;
        const u32x4 v = *(const u32x4*)(PROJ + m * NPROJ + COL_U + 8 * lane);
        *(u32x4*)(UG + ((size_t)g * SSM_ROWS + b * SSM_NCH + c) * SSM_K + 16 * j + 8 * hh) = v;
    }
}
__device__ __forceinline__ void mixer_prep(const Ptrs& P, int l, LAS unsigned char* lds, int vcu, int G, int tid, int lane, int wave) {
    for (int u = vcu; u < 256; u += G) compress_unit(P, l, u, lds, tid);
    for (int it = vcu; it < 2048; it += G) vtrans_item(P, it, lds, tid);
    ug_build(P, vcu, G, lane, wave);
}

__device__ __forceinline__ void ssm_scan(const Ptrs& P, int vcu, int G, int lane, int wave) {
    const float* SL = (const float*)(P.ws + WS_SLOC); bf16_t* UG = (bf16_t*)(P.ws + WS_UG); const float* A32 = (const float*)(P.ws + WS_MISC) + MS_A32;
    for (int it = vcu * NWAVES + wave; it < SSM_G * NB; it += G * NWAVES) {
        const int g = it >> 3, b = it & 7;
        const f32x2 a = *(const f32x2*)(A32 + (g * 64 + lane) * 2);
        float sr = 0.f, si = 0.f;
        const size_t row0 = (size_t)g * SSM_ROWS + b * SSM_NCH;
        for (int c0 = 0; c0 < SSM_NCH; c0 += 16) {
            f32x2 x[16];
#pragma unroll
            for (int k = 0; k < 16; ++k) x[k] = *(const f32x2*)(SL + (row0 + c0 + k) * 128 + 2 * lane);
#pragma unroll
            for (int k = 0; k < 16; ++k) {
                *(unsigned*)(UG + (row0 + c0 + k) * SSM_K + 512 + 2 * lane) = pk2(sr, si);
                const float nr = a.x * sr - a.y * si + x[k].x, ni = a.x * si + a.y * sr + x[k].y; sr = nr; si = ni;
            }
        }
    }
}

namespace att {
constexpr int KSTR = 72, TILE_B = 64 * KSTR * 2;
constexpr int OFF_K = 0, OFF_V = 2 * TILE_B, OFF_IMP = 4 * TILE_B, IMP_STR = 65, OFF_SEL = OFF_IMP + 8 * 32 * IMP_STR * 4, OFF_SC = OFF_SEL + 512;
constexpr float C2 = 0.125f * 1.4426950408889634f;
constexpr float NEG = -1.0e30f;
static_assert(OFF_SC + 8 * 64 * 4 <= 131072, "attention LDS");

__device__ __forceinline__ int kidx_of(int reg, int hi) { return (reg & 3) + 8 * (reg >> 2) + 4 * hi; }

template <int BR>
__device__ __forceinline__ void run_branch(LAS unsigned char* lds, int tid, unsigned long long tmask,
                                           const bf16_t* kbase, size_t kpitch, const bf16_t* vbase, size_t vpitch,
                                           const bf16x8 (&qf)[4], int t, int qt, int nvalid, unsigned long long mymask,
                                           float& m, float& l, f32x16 (&o)[2], float mfix, float invl, int wave) {
    const int lane = tid & 63, r32 = lane & 31, hi = lane >> 5;
    const int sr = tid >> 3, scc = tid & 7; const int soff = (sr * KSTR + scc * 8) * 2;
    constexpr bool HASV = (BR != 0);
    u32x4 kreg, vreg; float carry = 0.f;
    unsigned long long rem = tmask;
    if (rem == 0ull) return;
    int j = __builtin_ctzll(rem); rem &= rem - 1ull;
    kreg = *(const u32x4*)(kbase + (size_t)(j * 64 + sr) * kpitch + scc * 8);
    if (HASV) vreg = *(const u32x4*)(vbase + (size_t)sr * vpitch + j * 64 + scc * 8);
    *(LAS u32x4*)(lds + OFF_K + soff) = kreg; if (HASV) *(LAS u32x4*)(lds + OFF_V + soff) = vreg;
    __syncthreads();
    int buf = 0;
    for (;;) {
        const bool more = (rem != 0ull); int jn = 0;
        if (more) { jn = __builtin_ctzll(rem); rem &= rem - 1ull;
            kreg = *(const u32x4*)(kbase + (size_t)(jn * 64 + sr) * kpitch + scc * 8);
            if (HASV) vreg = *(const u32x4*)(vbase + (size_t)sr * vpitch + jn * 64 + scc * 8); }
        int lo = 0, hi_;
        if (BR <= 1) hi_ = nvalid - 1 - 64 * j;
        else if (BR == 2) hi_ = ((mymask >> j) & 1ull) ? ((j < qt) ? 63 : (t & 63)) : -1;
        else { lo = t - 511 - 64 * j; hi_ = t - 64 * j; }
        const LAS unsigned char* Kb = lds + OFF_K + buf * TILE_B;
        f32x16 p0 = {0.f, 0.f, 0.f, 0.f, 0.f, 0.f, 0.f, 0.f, 0.f, 0.f, 0.f, 0.f, 0.f, 0.f, 0.f, 0.f}, p1 = p0;
#pragma unroll
        for (int d0 = 0; d0 < 4; ++d0) {
            const bf16x8 k0 = *(const LAS bf16x8*)(Kb + (r32 * KSTR + d0 * 16 + hi * 8) * 2);
            const bf16x8 k1 = *(const LAS bf16x8*)(Kb + ((32 + r32) * KSTR + d0 * 16 + hi * 8) * 2);
            p0 = __builtin_amdgcn_mfma_f32_32x32x16_bf16(k0, qf[d0], p0, 0, 0, 0);
            p1 = __builtin_amdgcn_mfma_f32_32x32x16_bf16(k1, qf[d0], p1, 0, 0, 0);
        }
        float mref;
        if (BR == 1) mref = mfix;
        else {
            float mx = NEG;
#pragma unroll
            for (int r = 0; r < 16; ++r) { const int k0i = kidx_of(r, hi), k1i = k0i + 32;
                const float a = (k0i >= lo && k0i <= hi_) ? p0[r] * C2 : NEG, c = (k1i >= lo && k1i <= hi_) ? p1[r] * C2 : NEG;
                mx = fmaxf(mx, fmaxf(a, c)); }
            mx = fmaxf(mx, __shfl_xor(mx, 32));
            const float mnew = fmaxf(m, mx); const float alpha = __builtin_amdgcn_exp2f(m - mnew);
            l *= alpha;
            if (BR != 0) { o[0] *= alpha; o[1] *= alpha; }
            m = mnew; mref = mnew;
        }
        float ls = 0.f;
#pragma unroll
        for (int r = 0; r < 16; ++r) { const int k0i = kidx_of(r, hi), k1i = k0i + 32;
            float a = (k0i >= lo && k0i <= hi_) ? __builtin_amdgcn_exp2f(p0[r] * C2 - mref) : 0.f;
            float c = (k1i >= lo && k1i <= hi_) ? __builtin_amdgcn_exp2f(p1[r] * C2 - mref) : 0.f;
            if (BR == 1) { a *= invl; c *= invl; }
            p0[r] = a; p1[r] = c; ls += a + c; }
        l += ls;
        if (BR == 1) {
            LAS float* IW = (LAS float*)(lds + OFF_IMP) + (wave * 32 + r32) * IMP_STR + 16 * j + hi;
            float oth[8];
#pragma unroll
            for (int q = 0; q < 4; ++q) { oth[q] = __shfl_xor(p0[4 * q + 3], 32); oth[4 + q] = __shfl_xor(p1[4 * q + 3], 32); }
#pragma unroll
            for (int q = 0; q < 8; ++q) {
                const float core = (q < 4) ? ((p0[4 * q] + p0[4 * q + 1]) + (p0[4 * q + 2] + p0[4 * q + 3])) : ((p1[4 * (q - 4)] + p1[4 * (q - 4) + 1]) + (p1[4 * (q - 4) + 2] + p1[4 * (q - 4) + 3]));
                const float prev = (q == 0) ? carry : oth[q - 1];
                IW[2 * q] = core + (hi ? oth[q] : prev);
            }
            carry = oth[7];
        }
        if (BR != 0) {
            const LAS unsigned char* Vb = lds + OFF_V + buf * TILE_B;
#pragma unroll
            for (int s = 0; s < 4; ++s) {
                u32x4 pw;
                if (s == 0)      { pw.x = cvt_pk_bf16(p0[0], p0[1]);  pw.y = cvt_pk_bf16(p0[2], p0[3]);   pw.z = cvt_pk_bf16(p0[4], p0[5]);   pw.w = cvt_pk_bf16(p0[6], p0[7]); }
                else if (s == 1) { pw.x = cvt_pk_bf16(p0[8], p0[9]);  pw.y = cvt_pk_bf16(p0[10], p0[11]); pw.z = cvt_pk_bf16(p0[12], p0[13]); pw.w = cvt_pk_bf16(p0[14], p0[15]); }
                else if (s == 2) { pw.x = cvt_pk_bf16(p1[0], p1[1]);  pw.y = cvt_pk_bf16(p1[2], p1[3]);   pw.z = cvt_pk_bf16(p1[4], p1[5]);   pw.w = cvt_pk_bf16(p1[6], p1[7]); }
                else             { pw.x = cvt_pk_bf16(p1[8], p1[9]);  pw.y = cvt_pk_bf16(p1[10], p1[11]); pw.z = cvt_pk_bf16(p1[12], p1[13]); pw.w = cvt_pk_bf16(p1[14], p1[15]); }
                const bf16x8 pf = __builtin_bit_cast(bf16x8, pw);
#pragma unroll
                for (int db = 0; db < 2; ++db) {
                    const u32x2 vlo = *(const LAS u32x2*)(Vb + ((db * 32 + r32) * KSTR + s * 16 + 4 * hi) * 2);
                    const u32x2 vhi = *(const LAS u32x2*)(Vb + ((db * 32 + r32) * KSTR + s * 16 + 8 + 4 * hi) * 2);
                    const bf16x8 vf = __builtin_bit_cast(bf16x8, (u32x4){vlo.x, vlo.y, vhi.x, vhi.y});
                    o[db] = __builtin_amdgcn_mfma_f32_32x32x16_bf16(vf, pf, o[db], 0, 0, 0);
                }
            }
        }
        if (!more) break;
        buf ^= 1;
        *(LAS u32x4*)(lds + OFF_K + buf * TILE_B + soff) = kreg; if (HASV) *(LAS u32x4*)(lds + OFF_V + buf * TILE_B + soff) = vreg;
        j = jn;
        __syncthreads();
    }
    __syncthreads();
}

__device__ __forceinline__ void attn_unit(const Ptrs& P, int b, int h, int qt, LAS unsigned char* lds, int tid) {
    const int lane = tid & 63, wave = __builtin_amdgcn_readfirstlane(tid >> 6), r32 = lane & 31, hi = lane >> 5, gq = wave & 3, th = wave >> 2;
    const int t = qt * 64 + th * 32 + r32; const size_t m = (size_t)b * SEQ + t;
    const bf16_t* PROJ = (const bf16_t*)(P.ws + WS_PROJ);
    const bf16_t* prow0 = PROJ + (size_t)b * SEQ * NPROJ;
    bf16x8 qf[4];
#pragma unroll
    for (int d0 = 0; d0 < 4; ++d0) qf[d0] = *(const bf16x8*)(PROJ + m * NPROJ + COL_Q + h * 256 + gq * 64 + d0 * 16 + hi * 8);
    const float* gp = (const float*)(P.ws + WS_GATE) + m * 24 + h * 12 + gq * 3;
    const float g0 = gp[0], g1 = gp[1], g2 = gp[2];
    f32x16 outacc[2], o[2];
    const f32x16 zero16 = {0.f, 0.f, 0.f, 0.f, 0.f, 0.f, 0.f, 0.f, 0.f, 0.f, 0.f, 0.f, 0.f, 0.f, 0.f, 0.f};
    outacc[0] = zero16; outacc[1] = zero16;
    const int bh = b * 2 + h;
    const int nvalid = (t >= 31) ? ((t - 31) >> 4) + 1 : 0;
    const int nct = (4 * qt + 66) >> 6;
    const unsigned long long cmask = (nct >= 64) ? ~0ull : ((1ull << nct) - 1ull);
    const bf16_t* kc = (const bf16_t*)(P.ws + WS_KCMP) + (size_t)bh * NCMPP * 64; const bf16_t* vct = (const bf16_t*)(P.ws + WS_VCMPT) + (size_t)bh * 64 * NCMPP;
    float mm = NEG, ll = 0.f;
    run_branch<0>(lds, tid, cmask, kc, 64, nullptr, 0, qf, t, qt, nvalid, 0ull, mm, ll, o, 0.f, 0.f, wave);
    { const float lt = ll + __shfl_xor(ll, 32); const float invl = lt > 0.f ? 1.0f / lt : 0.f; const float mfix = mm;
      o[0] = zero16; o[1] = zero16; float m2 = mfix, l2 = 0.f;
      run_branch<1>(lds, tid, cmask, kc, 64, vct, NCMPP, qf, t, qt, nvalid, 0ull, m2, l2, o, mfix, invl, wave);
      outacc[0] += g0 * o[0]; outacc[1] += g0 * o[1]; }
    LAS unsigned long long* SEL = (LAS unsigned long long*)(lds + OFF_SEL);
    const unsigned long long causal_all = (qt >= 63) ? ~0ull : ((1ull << (qt + 1)) - 1ull);
    if (qt + 1 <= 16) { if (tid < 64) SEL[tid] = causal_all; }
    else {
        const LAS float* IW = (const LAS float*)(lds + OFF_IMP);
        for (int ti = 0; ti < 8; ++ti) {
            const int tk = wave * 8 + ti, thp = tk >> 5, r = tk & 31, s = lane;
            float imp = 0.f;
            if (s < 16 * nct) { const LAS float* q = IW + ((4 * thp) * 32 + r) * IMP_STR + s; imp = ((q[0] + q[32 * IMP_STR]) + q[64 * IMP_STR]) + q[96 * IMP_STR]; }
            const bool causal = s <= qt, forced = (s == 0) || (s == qt) || (s == qt - 1);
            const float score = causal ? (forced ? __builtin_inff() : imp) : -__builtin_inff();
            int rank = 0;
            LAS float* SC = (LAS float*)(lds + OFF_SC) + wave * 64;
            SC[lane] = score; LDS_WAIT();
#pragma unroll 2
            for (int sp = 0; sp < 64; sp += 4) { const f32x4 ov = *(const LAS f32x4*)(SC + sp);
                rank += (ov.x > score || (ov.x == score && sp + 0 < s)) ? 1 : 0; rank += (ov.y > score || (ov.y == score && sp + 1 < s)) ? 1 : 0;
                rank += (ov.z > score || (ov.z == score && sp + 2 < s)) ? 1 : 0; rank += (ov.w > score || (ov.w == score && sp + 3 < s)) ? 1 : 0; }
            LDS_WAIT();
            const unsigned long long bal = __ballot(rank < 16 && causal);
            if (lane == 0) SEL[tk] = bal;
        }
    }
    __syncthreads();
    const unsigned long long mymask = SEL[th * 32 + r32];
    unsigned long long un = 0ull;
#pragma unroll 8
    for (int i = 0; i < 64; ++i) un |= SEL[i];
    { float ms = NEG, ls = 0.f; o[0] = zero16; o[1] = zero16;
      const bf16_t* ks = prow0 + COL_KS + h * 64; const bf16_t* vst = (const bf16_t*)(P.ws + WS_VST) + (size_t)bh * 64 * SEQ;
      run_branch<2>(lds, tid, un, ks, NPROJ, vst, SEQ, qf, t, qt, nvalid, mymask, ms, ls, o, 0.f, 0.f, wave);
      const float lt = ls + __shfl_xor(ls, 32); const float sc = g1 * (lt > 0.f ? 1.0f / lt : 0.f);
      outacc[0] += sc * o[0]; outacc[1] += sc * o[1]; }
    { float mw = NEG, lw = 0.f; o[0] = zero16; o[1] = zero16;
      const int jlo = qt >= 8 ? qt - 8 : 0; const unsigned long long wmask = causal_all & ~((1ull << jlo) - 1ull);
      const bf16_t* kw = prow0 + COL_KW + h * 64; const bf16_t* vwt = (const bf16_t*)(P.ws + WS_VWT) + (size_t)bh * 64 * SEQ;
      run_branch<3>(lds, tid, wmask, kw, NPROJ, vwt, SEQ, qf, t, qt, nvalid, 0ull, mw, lw, o, 0.f, 0.f, wave);
      const float lt = lw + __shfl_xor(lw, 32); const float sc = g2 * (lt > 0.f ? 1.0f / lt : 0.f);
      outacc[0] += sc * o[0]; outacc[1] += sc * o[1]; }
    bf16_t* orow = (bf16_t*)(P.ws + WS_O) + m * DM + h * 256 + gq * 64;
#pragma unroll
    for (int db = 0; db < 2; ++db)
#pragma unroll
        for (int rq = 0; rq < 4; ++rq) { u32x2 w; w.x = cvt_pk_bf16(outacc[db][4 * rq], outacc[db][4 * rq + 1]); w.y = cvt_pk_bf16(outacc[db][4 * rq + 2], outacc[db][4 * rq + 3]);
            *(u32x2*)(orow + 32 * db + 8 * rq + 4 * hi) = w; }
}
__device__ __forceinline__ void attn_phase(const Ptrs& P, LAS unsigned char* lds, int vcu, int G, int tid) {
    for (int i = 0; i < 4; ++i) {
        const int u = i * G + vcu; if (u >= 1024) break;
        const int v = u & 255, k = u >> 8, bh = v >> 4, s = v & 15;
        const int qt = (k == 0) ? s : (k == 1) ? 31 - s : (k == 2) ? 32 + s : 63 - s;
        attn_unit(P, bh >> 1, bh & 1, qt, lds, tid);
    }
}
}

enum PhaseKind { PK_P0 = 0, PK_MOD0, PK_INPROJ, PK_MIXPREP, PK_SSMSTATE, PK_SCAN, PK_SSMY, PK_GLU, PK_ATTN, PK_RMS, PK_OUTPROJ, PK_LN1E, PK_FFNGU, PK_FFNDN, PK_LN2E,
                 PK_LN1O, PK_DISPATCH, PK_MOEGU, PK_MOEDN, PK_LN2O, PK_LN2LAST, PK_COUNT };

template <int PK>
__device__ __forceinline__ void phase_body(const Ptrs& P, int l, int ck, LAS unsigned char* lds, int tid, int bx) {
    const int lane = tid & 63, wave = __builtin_amdgcn_readfirstlane(tid >> 6); (void)lane; (void)wave;
    constexpr int G = pg8::NWG; const int vcu = (bx % 8) * (G / 8) + bx / 8; (void)vcu;
    float* MOD = (float*)(P.ws + WS_MOD);
    const float* modl = MOD + (size_t)l * 8 * 6144; const float* modn = MOD + (size_t)(l + 1) * 8 * 6144;
    const float* lng1 = P.in[I_LNG] + (size_t)(l * 2 + 0) * DM; const float* lnb1 = P.in[I_LNB] + (size_t)(l * 2 + 0) * DM;
    const float* lng2 = P.in[I_LNG] + (size_t)(l * 2 + 1) * DM; const float* lnb2 = P.in[I_LNB] + (size_t)(l * 2 + 1) * DM;
    bf16_t* HM = (bf16_t*)(P.ws + WS_HM); bf16_t* YO = (bf16_t*)(P.ws + WS_YO); bf16_t* PROJ = (bf16_t*)(P.ws + WS_PROJ); bf16_t* O = (bf16_t*)(P.ws + WS_O);
    bf16_t* UG = (bf16_t*)(P.ws + WS_UG); bf16_t* YG = (bf16_t*)(P.ws + WS_YG); bf16_t* HID = (bf16_t*)(P.ws + WS_HID); bf16_t* XS = (bf16_t*)(P.ws + WS_XS);
    (void)modl; (void)modn; (void)lng1; (void)lnb1; (void)lng2; (void)lnb2; (void)HM; (void)YO; (void)PROJ; (void)O; (void)UG; (void)YG; (void)HID; (void)XS; (void)ck;
    if constexpr (PK == PK_P0) p0_prologue(P, lds, vcu, G, tid, lane, wave);
    else if constexpr (PK == PK_MOD0) row_pass<0, 1, true>(P, lds, vcu, G, tid, lane, wave, nullptr, nullptr, nullptr, MOD + 1 * DM, MOD + 0 * DM, P.in[I_WIN] + 1280, 0);
    else if constexpr (PK == PK_INPROJ) {
        prep_layer(P, l, lds, vcu, G, tid, lane, wave);
        __syncthreads();
        pg8::Gemm g{HM, (const bf16_t*)(P.ws + WS_WIN) + (size_t)l * NPROJ * DM}; pg8::StaticOrder<128, 7> S{bx};
        pg8::EpiStore<NPROJ, 1024> E{PROJ, 0};
        pg8::gemm_phase<pg8::EpiStore<NPROJ, 1024>, pg8::StaticOrder<128, 7>, DM, DM, DM>(lds, g, S, E, tid);
    }
    else if constexpr (PK == PK_MIXPREP) mixer_prep(P, l, lds, vcu, G, tid, lane, wave);
    else if constexpr (PK == PK_SSMSTATE) {
        pg8::Gemm g{UG, (const bf16_t*)(P.ws + WS_SSME)}; pg8::SsmStateOrder S{bx};
        pg8::EpiSsmState E{(float*)(P.ws + WS_SLOC)};
        pg8::gemm_phase<pg8::EpiSsmState, pg8::SsmStateOrder, 512, SSM_K, 512>(lds, g, S, E, tid);
    }
    else if constexpr (PK == PK_SCAN) ssm_scan(P, vcu, G, lane, wave);
    else if constexpr (PK == PK_SSMY) {
        pg8::Gemm g{UG, (const bf16_t*)(P.ws + WS_SSMM)}; pg8::SsmYOrder S{bx};
        pg8::EpiSsmY E{YG};
        pg8::gemm_phase<pg8::EpiSsmY, pg8::SsmYOrder, SSM_K, SSM_K, SSM_K>(lds, g, S, E, tid);
    }
    else if constexpr (PK == PK_GLU) {
        pg8::Gemm g{YG, (const bf16_t*)(P.ws + WS_WGLU) + (size_t)l * 512 * 512}; pg8::StaticOrder<128, 2> S{bx};
        pg8::EpiGlu E{YG, O};
        pg8::gemm_phase<pg8::EpiGlu, pg8::StaticOrder<128, 2>, 512, 512, 512>(lds, g, S, E, tid);
    }
    else if constexpr (PK == PK_ATTN) att::attn_phase(P, lds, vcu, G, tid);
    else if constexpr (PK == PK_RMS) rms_pass(P, l, vcu, G, lane, wave);
    else if constexpr (PK == PK_OUTPROJ) {
        pg8::Gemm g{O, (const bf16_t*)(P.ws + WS_WOUT) + (size_t)l * DM * DM}; pg8::StaticOrder<128, 4> S{bx};
        pg8::EpiStore<DM, 1024> E{YO, 0};
        pg8::gemm_phase<pg8::EpiStore<DM, 1024>, pg8::StaticOrder<128, 4>, DM, DM, DM>(lds, g, S, E, tid);
    }
    else if constexpr (PK == PK_LN1E) row_pass<1, 0, true>(P, lds, vcu, G, tid, lane, wave, modl + 2 * DM, lng1, lnb1, modl + 4 * DM, modl + 3 * DM, nullptr, 0);
    else if constexpr (PK == PK_FFNGU) {
        pg8::Gemm g{HM, (const bf16_t*)(P.ws + WS_FGU) + (size_t)(l >> 1) * 5632 * DM}; pg8::StaticOrder<128, 22> S{bx};
        pg8::EpiSwiGLU E{HID, 0};
        pg8::gemm_phase<pg8::EpiSwiGLU, pg8::StaticOrder<128, 22>, DM, DM, DM>(lds, g, S, E, tid);
    }
    else if constexpr (PK == PK_FFNDN) {
        pg8::Gemm g{HID, (const bf16_t*)(P.ws + WS_FD) + (size_t)(l >> 1) * DM * DFF}; pg8::StaticOrder<128, 4> S{bx};
        pg8::EpiStore<DM, 1024> E{YO, 0};
        pg8::gemm_phase<pg8::EpiStore<DM, 1024>, pg8::StaticOrder<128, 4>, DFF, DFF, DFF>(lds, g, S, E, tid);
    }
    else if constexpr (PK == PK_LN2E) row_pass<1, 1, true>(P, lds, vcu, G, tid, lane, wave, modl + 5 * DM, lng2, lnb2, modn + 1 * DM, modn + 0 * DM, P.in[I_WIN] + (size_t)(l + 1) * DM * PWID + 1280, 0);
    else if constexpr (PK == PK_LN1O) row_pass<1, 2, true>(P, lds, vcu, G, tid, lane, wave, modl + 2 * DM, lng1, lnb1, modl + 4 * DM, modl + 3 * DM, P.in[I_ROUTER] + (size_t)(l >> 1) * DM * NEXP, l >> 1);
    else if constexpr (PK == PK_DISPATCH) moe_dispatch(P, l >> 1, vcu, G, lane, wave);
    else if constexpr (PK == PK_MOEGU) {
        const MoeOff mo = load_moe_off(P.ws, l >> 1); const int c0 = ck * 128; int nM = mo.t8 - c0; nM = nM > 128 ? 128 : nM; if (nM < 0) nM = 0;
        pg8::Gemm g{XS, (const bf16_t*)(P.ws + WS_MGU)}; pg8::MoeOrder<22> S{nM, bx, c0, c0, mo.t1, mo.t2, mo.t3, mo.t4, mo.t5, mo.t6, mo.t7};
        pg8::EpiSwiGLU E{HID, -c0 * 256};
        pg8::gemm_phase<pg8::EpiSwiGLU, pg8::MoeOrder<22>, DM, DM, DM>(lds, g, S, E, tid);
    }
    else if constexpr (PK == PK_MOEDN) {
        const MoeOff mo = load_moe_off(P.ws, l >> 1); const int c0 = ck * 128; int nM = mo.t8 - c0; nM = nM > 128 ? 128 : nM; if (nM < 0) nM = 0;
        pg8::Gemm g{HID, (const bf16_t*)(P.ws + WS_MD)}; pg8::MoeOrder<4> S{nM, bx, c0, 0, mo.t1, mo.t2, mo.t3, mo.t4, mo.t5, mo.t6, mo.t7};
        pg8::EpiStore<DM, 4> E{XS, c0 * 256};
        pg8::gemm_phase<pg8::EpiStore<DM, 4>, pg8::MoeOrder<4>, DFF, DFF, DFF>(lds, g, S, E, tid);
    }
    else if constexpr (PK == PK_LN2O) row_pass<2, 1, true>(P, lds, vcu, G, tid, lane, wave, modl + 5 * DM, lng2, lnb2, modn + 1 * DM, modn + 0 * DM, P.in[I_WIN] + (size_t)(l + 1) * DM * PWID + 1280, l >> 1);
    else if constexpr (PK == PK_LN2LAST) row_pass<2, 0, false>(P, lds, vcu, G, tid, lane, wave, modl + 5 * DM, lng2, lnb2, nullptr, nullptr, nullptr, l >> 1);
}

template <int PK>
__global__ void __launch_bounds__(NTHREADS, 2) k_phase(Ptrs P, int l, int ck) {
    extern __shared__ __attribute__((aligned(16))) unsigned char lds_raw[];
    phase_body<PK>(P, l, ck, (LAS unsigned char*)lds_raw, (int)threadIdx.x, (int)blockIdx.x);
}
template <int PK> static void launch_phase(const Ptrs& p, int l, int ck, hipStream_t stream) {
    static bool attr_done = false;
    if (!attr_done) { (void)hipFuncSetAttribute((const void*)k_phase<PK>, hipFuncAttributeMaxDynamicSharedMemorySize, LDS_BYTES); attr_done = true; }
    hipLaunchKernelGGL(k_phase<PK>, dim3(pg8::NWG), dim3(NTHREADS), LDS_BYTES, stream, p, l, ck);
}

extern "C" void kernel_launch(void* const* d_in, const int* in_sizes, int n_in, void* d_out, int out_size, void* d_ws, size_t ws_size, hipStream_t stream) {
    static int ok = 0;
    if (ok == 0) {
        if (n_in != 32 || out_size != MTOK * DM || ws_size < WS_END) { fprintf(stderr, "kernel_launch: unexpected problem (n_in %d, out %d, ws %zu < %zu); nothing launched\n", n_in, out_size, ws_size, (size_t)WS_END); ok = -1; return; }
        int dev = 0, cus = 0;
        if (hipGetDevice(&dev) != hipSuccess || hipDeviceGetAttribute(&cus, hipDeviceAttributeMultiprocessorCount, dev) != hipSuccess) { ok = -1; return; }
        if (cus != 256) { fprintf(stderr, "kernel_launch: built for 256 CUs, device has %d; nothing launched\n", cus); ok = -1; return; }
        ok = 1;
    }
    if (ok < 0) return;
    if (hipMemsetAsync((char*)d_ws + WS_CTL, 0, CTL_ZERO_BYTES, stream) != hipSuccess) return;
    Ptrs p{};
    for (int i = 0; i < 32; ++i) p.in[i] = (const float*)d_in[i];
    p.out = (float*)d_out; p.ws = (unsigned char*)d_ws; p.ph_lo = 0; p.ph_hi = 0;
    launch_phase<PK_P0>(p, 0, 0, stream);
    launch_phase<PK_MOD0>(p, 0, 0, stream);
    for (int l = 0; l < DEPTH; ++l) {
        launch_phase<PK_INPROJ>(p, l, 0, stream);
        launch_phase<PK_MIXPREP>(p, l, 0, stream);
        launch_phase<PK_SSMSTATE>(p, l, 0, stream);
        launch_phase<PK_SCAN>(p, l, 0, stream);
        launch_phase<PK_SSMY>(p, l, 0, stream);
        launch_phase<PK_GLU>(p, l, 0, stream);
        launch_phase<PK_ATTN>(p, l, 0, stream);
        launch_phase<PK_RMS>(p, l, 0, stream);
        launch_phase<PK_OUTPROJ>(p, l, 0, stream);
        if ((l & 1) == 0) {
            launch_phase<PK_LN1E>(p, l, 0, stream);
            launch_phase<PK_FFNGU>(p, l, 0, stream);
            launch_phase<PK_FFNDN>(p, l, 0, stream);
            launch_phase<PK_LN2E>(p, l, 0, stream);
        } else {
            launch_phase<PK_LN1O>(p, l, 0, stream);
            launch_phase<PK_DISPATCH>(p, l, 0, stream);
            for (int ck = 0; ck < 3; ++ck) { launch_phase<PK_MOEGU>(p, l, ck, stream); launch_phase<PK_MOEDN>(p, l, ck, stream); }
            if (l + 1 < DEPTH) launch_phase<PK_LN2O>(p, l, 0, stream); else launch_phase<PK_LN2LAST>(p, l, 0, stream);
        }
    }
}
```
